# Optimizing an MI355X kernel written in HIP

```python
import jax, jax.numpy as jnp
from jax import lax
import numpy as np

D_MODEL = 1024
BATCH = 2
SEQ = 8192
DEPTH = 1

CHUNK = 64
Q_BLOCK = 128
ATTN_HEADS = 8
HEAD_DIM = 64
ATTN_WIDTH = ATTN_HEADS * HEAD_DIM
CONV_WIDTH = D_MODEL - ATTN_WIDTH
CONV_GROUPS = 8
CONV_KERNEL = 31
IDX_HEADS = 8
IDX_DIM = 64
TOPK_MAX = 256
ROT_DIM = HEAD_DIM // 4
ROPE_THETA = 500000.0
D_FF = 4 * D_MODEL
N_MOD = 6
EPS = 1e-6
IN_SIZES = (ATTN_WIDTH, ATTN_WIDTH, ATTN_WIDTH, IDX_HEADS * IDX_DIM, IDX_DIM, IDX_HEADS, CONV_WIDTH, CONV_WIDTH)
IN_COLS = 3 * ATTN_WIDTH + IDX_HEADS * IDX_DIM + IDX_DIM + IDX_HEADS + 2 * CONV_WIDTH

kernel_name = "hybrid_dsa_conformer_adaln_layer"


def _split_points():
    pts, acc = [], 0
    for s in IN_SIZES[:-1]:
        acc += s
        pts.append(acc)
    return pts


def rms_norm(x, g):
    xf = x.astype(jnp.float32)
    y = xf * lax.rsqrt(jnp.mean(xf * xf, axis=-1, keepdims=True) + EPS)
    return (y * g.astype(jnp.float32)).astype(x.dtype)


def layer_norm(x, g, b):
    xf = x.astype(jnp.float32)
    mu = jnp.mean(xf, axis=-1, keepdims=True)
    var = jnp.mean(jnp.square(xf - mu), axis=-1, keepdims=True)
    y = (xf - mu) * lax.rsqrt(var + EPS)
    return (y * g.astype(jnp.float32) + b.astype(jnp.float32)).astype(x.dtype)


def rope_tables(seq_len, dtype):
    pos = jnp.arange(seq_len, dtype=jnp.float32)
    inv_freq = ROPE_THETA ** (-jnp.arange(0, ROT_DIM, 2, dtype=jnp.float32) / ROT_DIM)
    ang = pos[:, None] * inv_freq[None, :]
    return jnp.cos(ang).astype(dtype), jnp.sin(ang).astype(dtype)


def partial_rope(x, cos, sin):
    half = ROT_DIM // 2
    x1 = x[..., :half]
    x2 = x[..., half:ROT_DIM]
    c = cos[None, :, None, :]
    s = sin[None, :, None, :]
    return jnp.concatenate([x1 * c - x2 * s, x2 * c + x1 * s, x[..., ROT_DIM:]], axis=-1)


def dsa_sparse_attention(q, k, v, iq, ik, iw):
    B, S, H, dh = q.shape
    n_blk = S // Q_BLOCK
    top_k = min(TOPK_MAX, S // 4)
    key_chunk = jnp.arange(S) // CHUNK
    ik_f = ik.astype(jnp.float32)

    def block(i):
        start = i * Q_BLOCK
        q_b = lax.dynamic_slice_in_dim(q, start, Q_BLOCK, axis=1)
        iq_b = lax.dynamic_slice_in_dim(iq, start, Q_BLOCK, axis=1).astype(jnp.float32)
        iw_b = lax.dynamic_slice_in_dim(iw, start, Q_BLOCK, axis=1).astype(jnp.float32)
        q_chunk = (start + jnp.arange(Q_BLOCK)) // CHUNK
        admissible = key_chunk[None, :] <= q_chunk[:, None]
        rel = jax.nn.relu(jnp.einsum('bthd,bsd->bths', iq_b, ik_f) * (IDX_DIM ** -0.5))
        score = jnp.einsum('bths,bth->bts', rel, iw_b)
        score = jnp.where(admissible[None], score, -jnp.inf)
        _, idx = lax.top_k(score, top_k)
        valid = key_chunk[idx] <= q_chunk[None, :, None]
        k_sel = jax.vmap(lambda kb, ib: kb[ib])(k, idx)
        v_sel = jax.vmap(lambda vb, ib: vb[ib])(v, idx)
        logits = jnp.einsum('bthd,btkhd->bthk', q_b, k_sel).astype(jnp.float32) * (dh ** -0.5)
        logits = jnp.where(valid[:, :, None, :], logits, -jnp.inf)
        p = jax.nn.softmax(logits, axis=-1).astype(v.dtype)
        return jnp.einsum('bthk,btkhd->bthd', p, v_sel)

    out = lax.map(block, jnp.arange(n_blk))
    return jnp.transpose(out, (1, 0, 2, 3, 4)).reshape(B, S, H * dh)


def conformer_conv(a, g, w_dw, b_dw, ln_g, ln_b):
    u = a * jax.nn.sigmoid(g)
    u = jnp.pad(u, ((0, 0), (CONV_KERNEL - 1, 0), (0, 0)))
    y = lax.conv_general_dilated(u, w_dw[:, None, :], window_strides=(1,), padding='VALID',
                                 dimension_numbers=('NWC', 'WIO', 'NWC'),
                                 feature_group_count=CONV_WIDTH) + b_dw
    y = layer_norm(y, ln_g, ln_b)
    return jax.nn.silu(y)


def setup_inputs(seed: int = 0) -> dict:
    key = jax.random.key(seed)
    ks = jax.random.split(key, 20)

    def nrm(k, shape, scale):
        return jax.random.normal(k, shape, jnp.float32) * scale

    L = DEPTH
    return {
        "x": nrm(ks[0], (BATCH, SEQ, D_MODEL), 1.0),
        "c": nrm(ks[1], (BATCH, D_MODEL), 1.0),
        "w_ada": nrm(ks[2], (L, D_MODEL, N_MOD * D_MODEL), 0.5 * D_MODEL ** -0.5),
        "b_ada": nrm(ks[3], (L, N_MOD * D_MODEL), 0.02),
        "g_norm1": 1.0 + nrm(ks[4], (L, D_MODEL), 0.02),
        "w_in": nrm(ks[5], (L, D_MODEL, IN_COLS), D_MODEL ** -0.5),
        "g_q": 1.0 + nrm(ks[6], (L, HEAD_DIM), 0.02),
        "g_k": 1.0 + nrm(ks[7], (L, HEAD_DIM), 0.02),
        "w_dw": nrm(ks[8], (L, CONV_KERNEL, CONV_WIDTH), CONV_KERNEL ** -0.5),
        "b_dw": nrm(ks[9], (L, CONV_WIDTH), 0.02),
        "g_conv_ln": 1.0 + nrm(ks[10], (L, CONV_WIDTH), 0.02),
        "b_conv_ln": nrm(ks[11], (L, CONV_WIDTH), 0.02),
        "g_out_attn": 1.0 + nrm(ks[12], (L, ATTN_WIDTH), 0.02),
        "g_out_conv": 1.0 + nrm(ks[13], (L, CONV_WIDTH), 0.02),
        "w_out": nrm(ks[14], (L, D_MODEL, D_MODEL), D_MODEL ** -0.5),
        "g_norm2": 1.0 + nrm(ks[15], (L, D_MODEL), 0.02),
        "w_ff1": nrm(ks[16], (L, D_MODEL, D_FF), D_MODEL ** -0.5),
        "w_ff2": nrm(ks[17], (L, D_FF, D_MODEL), D_FF ** -0.5),
    }


def reference(x, c, w_ada, b_ada, g_norm1, w_in, g_q, g_k, w_dw, b_dw, g_conv_ln, b_conv_ln,
              g_out_attn, g_out_conv, w_out, g_norm2, w_ff1, w_ff2):
    B, S, _ = x.shape
    cos, sin = rope_tables(S, x.dtype)
    c_act = jax.nn.silu(c)
    split_pts = _split_points()
    for l in range(DEPTH):
        mod = (c_act @ w_ada[l] + b_ada[l])[:, None, :]
        sh1, sc1, gt1, sh2, sc2, gt2 = jnp.split(mod, N_MOD, axis=-1)

        h = rms_norm(x, g_norm1[l]) * (1.0 + sc1) + sh1
        u = h @ w_in[l]
        q, k, v, iq, ik, iw, ca, cg = jnp.split(u, split_pts, axis=-1)
        q = partial_rope(rms_norm(q.reshape(B, S, ATTN_HEADS, HEAD_DIM), g_q[l]), cos, sin)
        k = partial_rope(rms_norm(k.reshape(B, S, ATTN_HEADS, HEAD_DIM), g_k[l]), cos, sin)
        v = v.reshape(B, S, ATTN_HEADS, HEAD_DIM)
        iq = partial_rope(iq.reshape(B, S, IDX_HEADS, IDX_DIM), cos, sin)
        ik = partial_rope(ik.reshape(B, S, 1, IDX_DIM), cos, sin)[:, :, 0, :]
        iw = iw * (IDX_HEADS ** -0.5)
        attn = dsa_sparse_attention(q, k, v, iq, ik, iw)
        conv = conformer_conv(ca, cg, w_dw[l], b_dw[l], g_conv_ln[l], b_conv_ln[l])
        mixed = jnp.concatenate([rms_norm(attn, g_out_attn[l]), rms_norm(conv, g_out_conv[l])], axis=-1)
        x = x + gt1 * (mixed @ w_out[l])

        h2 = rms_norm(x, g_norm2[l]) * (1.0 + sc2) + sh2
        f = jnp.square(jax.nn.relu(h2 @ w_ff1[l])) @ w_ff2[l]
        x = x + gt2 * f
    return x
```

```cpp
#ifndef REPEAT_MASK
#define REPEAT_MASK 0
#endif
#define REP(k) for (int rep_ = 0; rep_ < (((REPEAT_MASK) >> (k)) & 1) + 1; ++rep_)
#include <hip/hip_runtime.h>
#include <hip/hip_cooperative_groups.h>
#include <cstdio>
#include <cstdint>
#include <cmath>
#include <type_traits>

#define LAS __attribute__((address_space(3)))
#define GAS __attribute__((address_space(1)))
typedef unsigned short u16;
typedef short s16x8 __attribute__((ext_vector_type(8)));
typedef short s16x4 __attribute__((ext_vector_type(4)));
typedef _Float16 h16x8 __attribute__((ext_vector_type(8)));
typedef __bf16 b16x8 __attribute__((ext_vector_type(8)));
typedef float f32x4 __attribute__((ext_vector_type(4)));
typedef float f32x16 __attribute__((ext_vector_type(16)));
typedef unsigned u32x4 __attribute__((ext_vector_type(4)));
typedef unsigned u32x2 __attribute__((ext_vector_type(2)));

constexpr int SEQ = 8192, NB = 2, M = NB * SEQ, DM = 1024, DFF = 4096;
constexpr int AW = 512, NH = 8, HD = 64, CW = 512, CK = 31;
constexpr int IN_COLS = 3144, N1 = 3328;
constexpr int C_Q = 0, C_K = 512, C_V = 1024, C_IQ = 1536, C_IK = 2048, C_IW = 2112, C_CA = 2120, C_CG = 2632;
constexpr float EPS = 1e-6f;
constexpr float QSCALE = 0.125f * 1.4426950408889634f;
constexpr float IWSCALE = 0.35355339059327373f * 0.125f;
constexpr float SM_OFF = 8.0f;

constexpr size_t MiB = 1u << 20;
constexpr size_t WS_CTL = 0, CTL_ZERO_BYTES = 64 * 1024;
constexpr size_t WS_MOD = 1 * MiB;
constexpr size_t WS_COS = 1 * MiB + 64 * 1024;
constexpr size_t WS_SIN = WS_COS + 256 * 1024;
constexpr size_t WS_WIN = 2 * MiB;
constexpr size_t WS_WOUT = 9 * MiB;
constexpr size_t WS_W1 = 240 * MiB;
constexpr size_t WS_W2 = 19 * MiB;
constexpr size_t WS_SSP = 27 * MiB;
constexpr size_t WS_SS2 = 27 * MiB + 512 * 1024;
constexpr size_t WS_IW = 28 * MiB;
constexpr size_t WS_CB = 28 * MiB + 512 * 1024;
constexpr size_t WS_IK = 29 * MiB;
constexpr size_t WS_H = 32 * MiB;
constexpr size_t WS_Q = 64 * MiB, WS_K = 80 * MiB, WS_V = 96 * MiB;
constexpr size_t WS_IQ = 112 * MiB;
constexpr size_t WS_GLU = 128 * MiB;
constexpr size_t WS_MASK = 144 * MiB;
constexpr size_t WS_ATT = 160 * MiB;
constexpr size_t WS_CONV = 176 * MiB;
constexpr size_t WS_X1B = 208 * MiB;
constexpr size_t WS_F1 = 32 * MiB;
constexpr size_t WS_END = 256 * MiB;
constexpr int CW_BAR = 4096;

constexpr int NWAVES = 8, NTHR = 512;
constexpr int LDS_BYTES = 147456;
constexpr int RING_BYTES = 131072;
constexpr int MISC_OFF = LDS_BYTES - 256;

__device__ __forceinline__ unsigned f2bf(float f) { unsigned u = __builtin_bit_cast(unsigned, f); return (u + 0x7fffu + ((u >> 16) & 1u)) >> 16; }
typedef float f32x2_t __attribute__((ext_vector_type(2))); typedef __bf16 bf16x2_t __attribute__((ext_vector_type(2)));
__device__ __forceinline__ unsigned pk2bf(float lo, float hi) { f32x2_t v = {lo, hi}; bf16x2_t b = __builtin_convertvector(v, bf16x2_t); return __builtin_bit_cast(unsigned, b); }
__device__ __forceinline__ unsigned pk2h(float lo, float hi) { _Float16 a = (_Float16)lo, b = (_Float16)hi; return (unsigned)__builtin_bit_cast(u16, a) | ((unsigned)__builtin_bit_cast(u16, b) << 16); }
__device__ __forceinline__ float bf2f(unsigned short v) { return __builtin_bit_cast(float, (unsigned)v << 16); }
__device__ __forceinline__ float wave_sum(float v) {
#pragma unroll
    for (int o = 1; o < 64; o <<= 1) v += __shfl_xor(v, o);
    return v;
}
__device__ __forceinline__ unsigned lds_add_u32(LAS unsigned* p, unsigned v) { return __hip_atomic_fetch_add(p, v, __ATOMIC_RELAXED, __HIP_MEMORY_SCOPE_WORKGROUP); }
__device__ __forceinline__ unsigned lds_or_u32(LAS unsigned* p, unsigned v) { return __hip_atomic_fetch_or(p, v, __ATOMIC_RELAXED, __HIP_MEMORY_SCOPE_WORKGROUP); }
__device__ __forceinline__ int opaque_tid() { int t = threadIdx.x; asm volatile("" : "+v"(t)); return t; }
#define LDS_WAIT() asm volatile("s_waitcnt lgkmcnt(0)" ::: "memory")
#define VM_WAIT() asm volatile("s_waitcnt vmcnt(0)" ::: "memory")

namespace pg8 {
constexpr int BM = 256, BK = 64, HALF = 128, HTB = HALF * BK * 2, STAGE_BYTES = 8 * HTB, NXCD = 8, WGM = 8;
__host__ __device__ __forceinline__ int lds_byte(int r, int c) { const int st = (r >> 4) * 2 + (c >> 5), rr = r & 15, cc = c & 31, ob = rr * 64 + cc * 2; return st * 1024 + (ob ^ (((ob >> 9) & 1) << 5)); }
__host__ __device__ __forceinline__ void stage_rc(int b, int& R, int& C) { const int st = b / 1024, sb = b % 1024, swz = sb ^ (((sb >> 9) & 1) << 5); R = (st >> 1) * 16 + swz / 64; C = (st & 1) * 32 + (swz % 64) / 2; }
__host__ __device__ __forceinline__ int perm32(int rho) { const int n = rho >> 4, i = rho & 15; return 8 * (i >> 2) + 4 * n + (i & 3); }
struct Unit { int pm, pn; };
struct Gemm { const u16* A; const u16* A2; const u16* Bt; const u16* Bt2; int M, N, K, lda, ksplit; };
struct StaticOrder {
    int nM, nN, nwg, G, c;
    __host__ __device__ void init(int M_, int N_, int G_, int c_) { nM = M_ / BM; nN = N_ / BM; nwg = nM * nN; G = G_; c = c_; }
    __host__ __device__ bool next(int i, Unit& u) const {
        const long L = (long)i * G + c; if (L >= nwg) return false;
        int wgid = (int)L; { const int q = nwg / NXCD, r = nwg % NXCD, xcd = wgid % NXCD, off = wgid / NXCD; wgid = (xcd < r ? xcd * (q + 1) : r * (q + 1) + (xcd - r) * q) + off; }
        const int nig = WGM * nN, gid = wgid / nig, fm = gid * WGM, gsz = (nM - fm) < WGM ? (nM - fm) : WGM;
        u.pm = fm + ((wgid % nig) % gsz); u.pn = (wgid % nig) / gsz; return true;
    }
};
template <bool F16> __device__ __forceinline__ f32x4 mma16(s16x8 a, s16x8 b, f32x4 c) {
    if constexpr (F16) return __builtin_amdgcn_mfma_f32_16x16x32_f16(__builtin_bit_cast(h16x8, a), __builtin_bit_cast(h16x8, b), c, 0, 0, 0);
    else return __builtin_amdgcn_mfma_f32_16x16x32_bf16(__builtin_bit_cast(b16x8, a), __builtin_bit_cast(b16x8, b), c, 0, 0, 0);
}
template <class Epi, bool F16>
__device__ __forceinline__ void gemm_phase(LAS unsigned char* lds, const Gemm g, const StaticOrder& S, const Epi& E) {
    const int tid = opaque_tid(), wid = __builtin_amdgcn_readfirstlane(tid >> 6), lane = tid & 63, wr = wid >> 2, wc = wid & 3, fr = lane & 15, fq = lane >> 4;
    const int K = g.K, nt = K / BK;
    unsigned voffA[2], voffB[2];
#pragma unroll
    for (int i = 0; i < 2; ++i) { int R, C; stage_rc(tid * 16 + i * 8192, R, C); const int Rb = Epi::PERM ? ((R & ~31) + perm32(R & 31)) : R;
        voffA[i] = (unsigned)(R * g.lda + C) * 2u; voffB[i] = (unsigned)(Rb * K + C) * 2u; }
    const size_t kstep = (size_t)(BK * 2);
    const size_t hstep = (size_t)HALF * K * 2;
    const size_t tstep = 2 * hstep;
    const size_t hstepA = (size_t)HALF * g.lda * 2, tstepA = 2 * hstepA;
    const int ksplit = g.ksplit;
    const unsigned ldsw = (unsigned)wid * 1024u;
    const int aoff = lds_byte(wr * 64 + fr, fq * 8), boff = lds_byte(wc * 32 + fr, fq * 8);
#define PG8_SA(b, h) (((b) * 2 + (h)) * HTB)
#define PG8_SB(b, h) ((4 + (b) * 2 + (h)) * HTB)
#define PG8_STAGE(bufoff, gbase, voff) do { _Pragma("unroll") for (int _i = 0; _i < 2; ++_i) \
        __builtin_amdgcn_global_load_lds((const unsigned*)((const char*)(gbase) + (voff)[_i]), (LAS unsigned*)(lds + (bufoff) + ldsw + _i * 8192), 16, 0, 0); } while (0)
#define PG8_LDA(dst, b, h) do { _Pragma("unroll") for (int m = 0; m < 4; ++m) _Pragma("unroll") for (int k = 0; k < 2; ++k) dst[m][k] = *(const LAS s16x8*)(lds + PG8_SA(b, h) + aoff + m * 2048 + k * 1024); } while (0)
#define PG8_LDB(dst, b, h) do { _Pragma("unroll") for (int n = 0; n < 2; ++n) _Pragma("unroll") for (int k = 0; k < 2; ++k) dst[n][k] = *(const LAS s16x8*)(lds + PG8_SB(b, h) + boff + n * 2048 + k * 1024); } while (0)
#define PG8_MMA(ai, bj, At, Bt) do { __builtin_amdgcn_s_setprio(1); _Pragma("unroll") for (int m = 0; m < 4; ++m) _Pragma("unroll") for (int n = 0; n < 2; ++n) _Pragma("unroll") for (int k = 0; k < 2; ++k) \
        acc[ai][bj][m][n] = mma16<F16>(Bt[n][k], At[m][k], acc[ai][bj][m][n]); __builtin_amdgcn_s_setprio(0); } while (0)
#define PG8_WAIT_V(n) asm volatile("s_waitcnt vmcnt(" #n ")" ::: "memory")
#define PG8_WAIT_L(n) asm volatile("s_waitcnt lgkmcnt(" #n ")" ::: "memory")
#define PG8_BAR __builtin_amdgcn_s_barrier()
#define PG8_SCHED __builtin_amdgcn_sched_barrier(0)
    Unit cur, nxt; int ui = 0;
    if (!S.next(0, cur)) return;
    f32x4 acc[2][2][4][2];
#pragma unroll
    for (int a = 0; a < 2; ++a)
#pragma unroll
        for (int b = 0; b < 2; ++b)
#pragma unroll
            for (int m = 0; m < 4; ++m)
#pragma unroll
                for (int n = 0; n < 2; ++n) acc[a][b][m][n] = (f32x4){0.f, 0.f, 0.f, 0.f};
    s16x8 At[4][2], B0[2][2], B1[2][2];
    float midrs[2][4];
    if constexpr (Epi::HAS_MID) E.pre(midrs, cur, wr, fr);
#define PG8_BSEL(u_) ((g.Bt2 && (u_).pm * BM >= g.M / 2) ? (const char*)g.Bt2 : (const char*)g.Bt)
#define PG8_AT(b1, b2, t_) ((t_) < ksplit ? (b1) + (size_t)(t_) * kstep : (b2) + (size_t)((t_) - ksplit) * kstep)
    const char* cA = (const char*)g.A + (size_t)cur.pm * tstepA; const char* cA2 = (const char*)g.A2 + (size_t)cur.pm * tstepA; const char* cB = PG8_BSEL(cur) + (size_t)cur.pn * tstep;
    PG8_STAGE(PG8_SB(0, 0), cB, voffB); PG8_STAGE(PG8_SB(0, 1), cB + hstep, voffB); PG8_STAGE(PG8_SA(0, 0), cA, voffA); PG8_STAGE(PG8_SA(0, 1), cA + hstepA, voffA);
    if (wr == 1) PG8_BAR;
    PG8_WAIT_V(2); PG8_BAR;
    PG8_STAGE(PG8_SB(1, 0), cB + kstep, voffB); PG8_STAGE(PG8_SA(1, 0), cA + kstep, voffA); PG8_STAGE(PG8_SB(1, 1), cB + hstep + kstep, voffB);
    PG8_WAIT_V(6); PG8_BAR;
    for (;;) {
        const bool has_next = S.next(ui + 1, nxt);
        const char* nA = has_next ? (const char*)g.A + (size_t)nxt.pm * tstepA : cA; const char* nA2 = has_next ? (const char*)g.A2 + (size_t)nxt.pm * tstepA : cA2; const char* nB = has_next ? PG8_BSEL(nxt) + (size_t)nxt.pn * tstep : cB;
        for (int t = 0; t < nt; t += 2) {
            const bool last = (t == nt - 2);
            const char* a1 = PG8_AT(cA, cA2, t + 1);
            const char* a2 = last ? nA : PG8_AT(cA, cA2, t + 2); const char* b2 = last ? nB : cB + (size_t)(t + 2) * kstep;
            const char* a3 = last ? nA + kstep : PG8_AT(cA, cA2, t + 3); const char* b3 = b2 + kstep;
            PG8_LDB(B0, 0, 0); PG8_LDB(B1, 0, 1); PG8_SCHED; PG8_LDA(At, 0, 0); PG8_STAGE(PG8_SA(1, 1), a1 + hstepA, voffA);
            PG8_WAIT_V(8); PG8_WAIT_L(0); PG8_BAR; PG8_MMA(0, 0, At, B0); PG8_MMA(0, 1, At, B1); PG8_BAR; PG8_SCHED;
            PG8_LDA(At, 0, 1); PG8_STAGE(PG8_SB(0, 0), b2, voffB); PG8_STAGE(PG8_SB(0, 1), b2 + hstep, voffB); PG8_STAGE(PG8_SA(0, 0), a2, voffA);
            PG8_WAIT_V(8); PG8_WAIT_L(0); PG8_BAR; PG8_MMA(1, 0, At, B0); PG8_MMA(1, 1, At, B1); PG8_BAR; PG8_SCHED;
            PG8_LDB(B0, 1, 0); PG8_LDB(B1, 1, 1); PG8_SCHED; PG8_LDA(At, 1, 0); PG8_STAGE(PG8_SA(0, 1), a2 + hstepA, voffA);
            PG8_WAIT_V(8); PG8_WAIT_L(0); PG8_BAR; PG8_MMA(0, 0, At, B0); PG8_MMA(0, 1, At, B1); PG8_BAR; PG8_SCHED;
            PG8_LDA(At, 1, 1); PG8_STAGE(PG8_SB(1, 0), b3, voffB); PG8_STAGE(PG8_SB(1, 1), b3 + hstep, voffB); PG8_STAGE(PG8_SA(1, 0), a3, voffA);
            PG8_WAIT_V(8); PG8_WAIT_L(0); PG8_BAR; PG8_MMA(1, 0, At, B0); PG8_MMA(1, 1, At, B1); PG8_BAR; PG8_SCHED;
            if constexpr (Epi::HAS_MID) { if (t + 2 == ksplit) E.mid(acc, midrs); }
        }
        if (wr == 0) PG8_BAR;
        E(acc, cur, wr, wc, fr, fq);
        if (!has_next) break;
#pragma unroll
        for (int a = 0; a < 2; ++a)
#pragma unroll
            for (int b = 0; b < 2; ++b)
#pragma unroll
                for (int m = 0; m < 4; ++m)
#pragma unroll
                    for (int n = 0; n < 2; ++n) acc[a][b][m][n] = (f32x4){0.f, 0.f, 0.f, 0.f};
        cur = nxt; cA = nA; cA2 = nA2; cB = nB; ++ui;
        if constexpr (Epi::HAS_MID) E.pre(midrs, cur, wr, fr);
        if (wr == 1) PG8_BAR;
    }
    PG8_WAIT_V(0);
    PG8_BAR;
#undef PG8_BSEL
#undef PG8_AT
#undef PG8_SA
#undef PG8_SB
#undef PG8_STAGE
#undef PG8_LDA
#undef PG8_LDB
#undef PG8_MMA
#undef PG8_WAIT_V
#undef PG8_WAIT_L
#undef PG8_BAR
#undef PG8_SCHED
}
}

#define XB_TMO      128
#define XB_XCNT(j)  (256  + 64 * (j))
#define XB_XSUB(j)  (1280 + 64 * (j))
#define XB_XGEN(j)  (2304 + 64 * (j))
#define XB_TOP      3328
#define XB_TOPGEN   3392
#define XCD_BAR_WORDS 3456
#define XB_SPIN_CAP (1u << 18)
__device__ __forceinline__ unsigned xb_ld(unsigned* p)              { return __hip_atomic_load(p, __ATOMIC_RELAXED, __HIP_MEMORY_SCOPE_AGENT); }
__device__ __forceinline__ unsigned xb_add(unsigned* p, unsigned v) { return __hip_atomic_fetch_add(p, v, __ATOMIC_RELAXED, __HIP_MEMORY_SCOPE_AGENT); }
__device__ __forceinline__ unsigned xb_xcc_id() { return (unsigned)__builtin_amdgcn_s_getreg((3 << 11) | 20) & 0xFu; }
#define XB_SPIN(cond, bar) do { unsigned _sp = 0; while (cond) { __builtin_amdgcn_s_sleep(1); \
    if ((++_sp & 255u) == 0u) { if (xb_ld(&(bar)[XB_TMO])) break; if (_sp > XB_SPIN_CAP) { atomicAdd(&(bar)[XB_TMO], 1u); break; } } } } while (0)
struct XcdBarrier { unsigned* bar; unsigned x; volatile LAS unsigned* st; };
__device__ __forceinline__ XcdBarrier xcd_barrier_post(unsigned* bar, volatile LAS unsigned* st) {
    XcdBarrier b; b.bar = bar; b.x = xb_xcc_id(); b.st = st;
    if (threadIdx.x == 0) (void)xb_add(&bar[XB_XCNT(b.x)], 1u);
    return b;
}
__device__ __forceinline__ void xcd_barrier_complete(unsigned* bar, unsigned x, unsigned& nloc, unsigned& nx) {
    const unsigned G = gridDim.x * gridDim.y * gridDim.z;
    unsigned sum, cnt, mine, sp = 0u;
    for (;;) {
        sum = 0u; cnt = 0u; mine = 0u;
#pragma unroll
        for (unsigned j = 0; j < 16; ++j) { const unsigned c = xb_ld(&bar[XB_XCNT(j)]); sum += c; cnt += (c > 0u) ? 1u : 0u; mine = (j == x) ? c : mine; }
        if (sum == G) break;
        __builtin_amdgcn_s_sleep(1);
        if ((++sp & 255u) == 0u) { if (xb_ld(&bar[XB_TMO])) break; if (sp > XB_SPIN_CAP) { atomicAdd(&bar[XB_TMO], 1u); break; } }
    }
    nloc = mine > 0u ? mine : 1u; nx = cnt > 0u ? cnt : 1u;
}
__device__ __forceinline__ void xcd_barrier(const XcdBarrier& b) {
    asm volatile("s_waitcnt vmcnt(0)" ::: "memory");
    __syncthreads();
    if (threadIdx.x == 0) {
        unsigned* bar = b.bar;
        __builtin_amdgcn_s_waitcnt(0);
        unsigned nloc = b.st[0], nx = b.st[1];
        if (nloc == 0u) { xcd_barrier_complete(bar, b.x, nloc, nx); b.st[0] = nloc; b.st[1] = nx; }
        const unsigned old = xb_add(&bar[XB_XSUB(b.x)], 1u);
        const unsigned gen = old / nloc;
        if (old + 1u == (gen + 1u) * nloc) {
            __builtin_amdgcn_fence(__ATOMIC_RELEASE, "agent");
            asm volatile("s_waitcnt vmcnt(0)" ::: "memory");
            const unsigned og = xb_add(&bar[XB_TOP], 1u);
            const unsigned tg = og / nx;
            if (og + 1u == (tg + 1u) * nx) xb_add(&bar[XB_TOPGEN], 1u);
            else XB_SPIN(xb_ld(&bar[XB_TOPGEN]) == tg, bar);
            __builtin_amdgcn_fence(__ATOMIC_ACQUIRE, "agent");
            xb_add(&bar[XB_XGEN(b.x)], 1u);
            asm volatile("s_waitcnt vmcnt(0)" ::: "memory");
        } else {
            XB_SPIN(xb_ld(&bar[XB_XGEN(b.x)]) == gen, bar);
            __builtin_amdgcn_fence(__ATOMIC_ACQUIRE, "agent");
            asm volatile("s_waitcnt vmcnt(0)" ::: "memory");
        }
    }
    __syncthreads();
}

struct Params {
    const float *x, *c, *w_ada, *b_ada, *g_norm1, *w_in, *g_q, *g_k, *w_dw, *b_dw, *g_conv_ln, *b_conv_ln, *g_out_attn, *g_out_conv, *w_out, *g_norm2, *w_ff1, *w_ff2;
    float* out; unsigned char* ws;
};

template <bool F16, class SrcCol>
__device__ __forceinline__ void transpose_item(const float* W, int K, int Nsrc, u16* WT, const float* rs, LAS float* scr, int item, int nblk, int lane, SrcCol srccol, const float* rs2 = nullptr) {
    const int kb = item / nblk, nb = item % nblk, k0 = 64 * kb, n0 = 32 * nb;
    const int c4 = (lane & 7) * 4, r8 = lane >> 3; const int sc = srccol(n0 + c4); const bool run4 = sc >= 0 && srccol(n0 + c4 + 3) == sc + 3;
    f32x4 v[8];
    if (run4) {
#pragma unroll
        for (int i = 0; i < 8; ++i) v[i] = *(const f32x4*)(W + (size_t)(k0 + r8 + 8 * i) * Nsrc + sc);
    } else {
#pragma unroll
        for (int i = 0; i < 8; ++i)
#pragma unroll
            for (int e = 0; e < 4; ++e) { const int s1 = srccol(n0 + c4 + e); v[i][e] = s1 >= 0 ? W[(size_t)(k0 + r8 + 8 * i) * Nsrc + s1] : 0.f; }
    }
#pragma unroll
    for (int i = 0; i < 8; ++i) { const int kk = r8 + 8 * i; float sc1 = 1.f; if (rs) sc1 = rs[k0 + kk]; if (rs2) sc1 *= 1.f + rs2[k0 + kk];
#pragma unroll
        for (int e = 0; e < 4; ++e) scr[kk * 33 + c4 + e] = v[i][e] * sc1; }
    LDS_WAIT(); asm volatile("" ::: "memory");
    const int c = lane & 7;
#pragma unroll
    for (int j = 0; j < 4; ++j) { const int n = (lane >> 3) + 8 * j; const LAS float* s = scr + (8 * c) * 33 + n;
        u32x4 o;
        if (F16) { o.x = pk2h(s[0 * 33], s[1 * 33]); o.y = pk2h(s[2 * 33], s[3 * 33]); o.z = pk2h(s[4 * 33], s[5 * 33]); o.w = pk2h(s[6 * 33], s[7 * 33]); }
        else { o.x = pk2bf(s[0 * 33], s[1 * 33]); o.y = pk2bf(s[2 * 33], s[3 * 33]); o.z = pk2bf(s[4 * 33], s[5 * 33]); o.w = pk2bf(s[6 * 33], s[7 * 33]); }
        *(u32x4*)(WT + (size_t)(n0 + n) * K + k0 + 8 * c) = o; }
    LDS_WAIT(); asm volatile("" ::: "memory");
}
__device__ __forceinline__ int win_srccol(int p) {
    const int pn = p >> 8, r = p & 255, bj = r >> 7, wc = (r >> 5) & 3, i = r & 31;
    if (pn < 6) { const int base = (pn >> 1) * 512; const int head = 4 * (pn & 1) + wc; return base + head * 64 + 32 * bj + i; }
    if (pn < 10) { const int ch = 128 * (pn - 6) + 32 * wc + i; return (bj == 0 ? C_CA : C_CG) + ch; }
    if (pn < 12) { const int head = 4 * (pn - 10) + wc; return C_IQ + head * 64 + 32 * bj + i; }
    if (wc == 0) return C_IK + 32 * bj + i;
    if (wc == 1 && bj == 0 && i < 8) return C_IW + i;
    return -1;
}
__device__ __forceinline__ void p0_phase(const Params& p, LAS unsigned char* lds, int vcu, int G, int tid, int wave, int lane) {
    unsigned char* ws = p.ws;
    { float* cosT = (float*)(ws + WS_COS); float* sinT = (float*)(ws + WS_SIN);
      for (int e = vcu * NTHR + tid; e < SEQ * 8; e += G * NTHR) { const int pos = e >> 3, i = e & 7;
          const float inv = (float)pow(500000.0, -(double)i / 8.0); const float ang = (float)pos * inv; const double a = (double)ang;
          cosT[e] = (float)cos(a); sinT[e] = (float)sin(a); } }
    if (vcu < 192) {
        LAS float* sc = (LAS float*)lds;
        LAS float* red = (LAS float*)(lds + 8192);
        for (int e = tid; e < 2048; e += NTHR) { const float v = p.c[e]; sc[e] = v / (1.f + __expf(-v)); }
        __syncthreads();
        const int kl = tid >> 3, cq = tid & 7, c0 = vcu * 32 + cq * 4;
        f32x4 a0 = {0.f, 0.f, 0.f, 0.f}, a1 = {0.f, 0.f, 0.f, 0.f};
        f32x4 wv[16];
#pragma unroll
        for (int i = 0; i < 16; ++i) wv[i] = __builtin_nontemporal_load((const f32x4*)(p.w_ada + (size_t)(kl + 64 * i) * 6144 + c0));
#pragma unroll
        for (int i = 0; i < 16; ++i) { const int k = kl + 64 * i; a0 += wv[i] * sc[k]; a1 += wv[i] * sc[1024 + k]; }
        *(LAS f32x4*)(red + (kl * 8 + cq) * 8) = a0; *(LAS f32x4*)(red + (kl * 8 + cq) * 8 + 4) = a1;
        __syncthreads();
        if (tid < 64) { const int cq2 = tid >> 3, j = tid & 7; float s = 0.f;
            for (int k2 = 0; k2 < 64; ++k2) s += red[(k2 * 8 + cq2) * 8 + j];
            const int b = j >> 2, col = vcu * 32 + cq2 * 4 + (j & 3);
            ((float*)(ws + WS_MOD))[b * 6144 + col] = s + p.b_ada[col]; }
        __syncthreads();
    }
    LAS float* scr = (LAS float*)(lds + 32768 + wave * 8704);
    const int gw = vcu * NWAVES + wave, NGW = G * NWAVES;
    constexpr int I_IN = (DM / 64) * (N1 / 32), I_O = (DM / 64) * (DM / 32), I_1 = (DM / 64) * (DFF / 32), I_2 = (DFF / 64) * (DM / 32);
    { float* ss2 = (float*)(ws + WS_SS2); for (int e = vcu * NTHR + tid; e < M; e += G * NTHR) ss2[e] = 0.f; }
    for (int it = gw; it < I_IN; it += NGW)
        transpose_item<true>(p.w_in, DM, IN_COLS, (u16*)(ws + WS_WIN), nullptr, scr, it, N1 / 32, lane, [](int n) { return win_srccol(n); });
}
__device__ __forceinline__ void late_weights(const Params& p, LAS unsigned char* lds, int widx, int nw, int wave, int lane) {
    unsigned char* ws = p.ws; const float* mod = (const float*)(ws + WS_MOD);
    LAS float* scr = (LAS float*)(lds + 32768 + wave * 8704);
    constexpr int I_O = (DM / 64) * (DM / 32), I_1 = (DM / 64) * (DFF / 32), I_2 = (DFF / 64) * (DM / 32);
    for (int it = widx; it < I_O + I_2 + 2 * I_1; it += nw) {
        int r = it;
        if (r < I_O) { const int kb = r / (DM / 32); const float* rs = (kb < 8) ? p.g_out_attn : (p.g_out_conv - 512);
            transpose_item<false>(p.w_out, DM, DM, (u16*)(ws + WS_WOUT), rs, scr, r, DM / 32, lane, [](int n) { return n; }); continue; } r -= I_O;
        if (r < I_2) { transpose_item<false>(p.w_ff2, DFF, DM, (u16*)(ws + WS_W2), nullptr, scr, r, DM / 32, lane, [](int n) { return n; }); continue; } r -= I_2;
        const int b = r / I_1; r -= b * I_1;
        transpose_item<false>(p.w_ff1, DM, DFF, (u16*)(ws + WS_W1) + (size_t)b * DFF * DM, p.g_norm2, scr, r, DFF / 32, lane, [](int n) { return n; }, mod + b * 6144 + 4096);
    }
}

__device__ __forceinline__ void p1_rows(const Params& p, int gw, int NGW, int lane) {
    const float* mod = (const float*)(p.ws + WS_MOD); u16* H = (u16*)(p.ws + WS_H);
    for (int m0 = gw * 4; m0 < M; m0 += NGW * 4) {
        f32x4 v[4][4];
#pragma unroll
        for (int r = 0; r < 4; ++r) { const f32x4* xr = (const f32x4*)(p.x + (size_t)(m0 + r) * DM) + lane;
#pragma unroll
            for (int j = 0; j < 4; ++j) v[r][j] = __builtin_nontemporal_load(xr + 64 * j); }
        const int b = m0 / SEQ; const float* sh = mod + b * 6144; const float* scl = mod + b * 6144 + 1024;
        f32x4 gm[4], hm[4];
#pragma unroll
        for (int j = 0; j < 4; ++j) { const int c = 4 * lane + 256 * j; const f32x4 g = *(const f32x4*)(p.g_norm1 + c), s1 = *(const f32x4*)(scl + c); gm[j] = g * (s1 + 1.f); hm[j] = *(const f32x4*)(sh + c); }
#pragma unroll
        for (int r = 0; r < 4; ++r) { float s = 0.f;
#pragma unroll
            for (int j = 0; j < 4; ++j) s += (v[r][j].x * v[r][j].x + v[r][j].y * v[r][j].y) + (v[r][j].z * v[r][j].z + v[r][j].w * v[r][j].w);
            const float rstd = 1.f / sqrtf(wave_sum(s) * (1.f / DM) + EPS);
            unsigned long long* o8 = (unsigned long long*)(H + (size_t)(m0 + r) * DM) + lane;
#pragma unroll
            for (int j = 0; j < 4; ++j) { const f32x4 y = v[r][j] * rstd * gm[j] + hm[j];
                o8[64 * j] = (unsigned long long)pk2h(y.x, y.y) | ((unsigned long long)pk2h(y.z, y.w) << 32); } }
    }
}

__device__ __forceinline__ void p1_extra(const Params& p, LAS unsigned char* lds, int vcu, int G, int tid, int wave, int lane) {
    unsigned char* ws = p.ws; const float* mod = (const float*)(ws + WS_MOD);
    if (vcu < 128) {
        LAS float* red = (LAS float*)lds;
        const int kl = tid >> 3, cq = tid & 7, c0 = vcu * 32 + cq * 4;
        f32x4 a0 = {0.f, 0.f, 0.f, 0.f}, a1 = {0.f, 0.f, 0.f, 0.f};
        f32x4 wv[16];
#pragma unroll
        for (int i = 0; i < 16; ++i) wv[i] = *(const f32x4*)(p.w_ff1 + (size_t)(kl + 64 * i) * DFF + c0);
#pragma unroll
        for (int i = 0; i < 16; ++i) { const int k = kl + 64 * i; a0 += wv[i] * mod[3072 + k]; a1 += wv[i] * mod[6144 + 3072 + k]; }
        *(LAS f32x4*)(red + (kl * 8 + cq) * 8) = a0; *(LAS f32x4*)(red + (kl * 8 + cq) * 8 + 4) = a1;
        __syncthreads();
        if (tid < 64) { const int cq2 = tid >> 3, j = tid & 7; float s = 0.f;
            for (int k2 = 0; k2 < 64; ++k2) s += red[(k2 * 8 + cq2) * 8 + j];
            const int b = j >> 2, col = vcu * 32 + cq2 * 4 + (j & 3);
            ((float*)(ws + WS_CB))[b * DFF + col] = s; }
        __syncthreads();
    }
}
struct EpiInProj {
    static constexpr bool PERM = true, HAS_MID = false;
    unsigned char* ws; const float* g_q; const float* g_k;
    __device__ __forceinline__ void operator()(const f32x4 (&acc)[2][2][4][2], const pg8::Unit& u, int wr, int wc, int fr, int fq) const {
        const int pn = u.pn; const int row0 = u.pm * 256 + wr * 64 + fr;
        const float* cosT = (const float*)(ws + WS_COS); const float* sinT = (const float*)(ws + WS_SIN);
        if (pn < 6 || pn == 10 || pn == 11 || (pn == 12 && wc == 0)) {
            const int kind = pn < 6 ? (pn >> 1) : (pn < 12 ? 3 : 4);
            const bool donorm = kind < 2, dorope = kind != 2, f16o = kind >= 3;
            const int head = kind < 3 ? 4 * (pn & 1) + wc : (kind == 3 ? 4 * (pn - 10) + wc : 0);
            u16* dst = (u16*)(ws + (kind == 0 ? WS_Q : kind == 1 ? WS_K : kind == 2 ? WS_V : kind == 3 ? WS_IQ : WS_IK));
            const int ld = kind == 4 ? 64 : 512;
            const float* gg = kind == 0 ? g_q : g_k;
            float gv[2][8];
#pragma unroll
            for (int bj = 0; bj < 2; ++bj)
#pragma unroll
                for (int e = 0; e < 8; ++e) gv[bj][e] = donorm ? gg[32 * bj + 8 * fq + e] * (kind == 0 ? QSCALE : 1.f) : 1.f;
#pragma unroll
            for (int ai = 0; ai < 2; ++ai)
#pragma unroll
                for (int m = 0; m < 4; ++m) {
                    const int row = row0 + ai * 128 + m * 16; const int pos = row & (SEQ - 1);
                    float v[2][8];
#pragma unroll
                    for (int bj = 0; bj < 2; ++bj)
#pragma unroll
                        for (int n = 0; n < 2; ++n)
#pragma unroll
                            for (int e = 0; e < 4; ++e) v[bj][4 * n + e] = acc[ai][bj][m][n][e];
                    float rstd = 1.f;
                    if (donorm) { float ss = 0.f;
#pragma unroll
                        for (int bj = 0; bj < 2; ++bj)
#pragma unroll
                            for (int e = 0; e < 8; ++e) ss += v[bj][e] * v[bj][e];
                        ss += __shfl_xor(ss, 16); ss += __shfl_xor(ss, 32);
                        rstd = 1.f / sqrtf(ss * (1.f / 64.f) + EPS); }
#pragma unroll
                    for (int bj = 0; bj < 2; ++bj)
#pragma unroll
                        for (int e = 0; e < 8; ++e) v[bj][e] = v[bj][e] * rstd * gv[bj][e];
                    if (dorope) {
                        const f32x4 c0 = *(const f32x4*)(cosT + pos * 8), c1 = *(const f32x4*)(cosT + pos * 8 + 4), s0 = *(const f32x4*)(sinT + pos * 8), s1 = *(const f32x4*)(sinT + pos * 8 + 4);
#pragma unroll
                        for (int e = 0; e < 8; ++e) { const float pv = __shfl_xor(v[0][e], 16); const float cc = e < 4 ? c0[e & 3] : c1[e & 3], sn = e < 4 ? s0[e & 3] : s1[e & 3];
                            const float r1 = v[0][e] * cc - pv * sn, r2 = v[0][e] * cc + pv * sn; v[0][e] = fq == 0 ? r1 : (fq == 1 ? r2 : v[0][e]); }
                    }
#pragma unroll
                    for (int bj = 0; bj < 2; ++bj) { u32x4 w;
                        if (f16o) { w.x = pk2h(v[bj][0], v[bj][1]); w.y = pk2h(v[bj][2], v[bj][3]); w.z = pk2h(v[bj][4], v[bj][5]); w.w = pk2h(v[bj][6], v[bj][7]); }
                        else { w.x = pk2bf(v[bj][0], v[bj][1]); w.y = pk2bf(v[bj][2], v[bj][3]); w.z = pk2bf(v[bj][4], v[bj][5]); w.w = pk2bf(v[bj][6], v[bj][7]); }
                        *(u32x4*)(dst + (size_t)row * ld + head * 64 + 32 * bj + 8 * fq) = w; }
                }
        } else if (pn < 10) {
            u16* dst = (u16*)(ws + WS_GLU);
#pragma unroll
            for (int ai = 0; ai < 2; ++ai)
#pragma unroll
                for (int m = 0; m < 4; ++m) { const int row = row0 + ai * 128 + m * 16; float o[8];
#pragma unroll
                    for (int n = 0; n < 2; ++n)
#pragma unroll
                        for (int e = 0; e < 4; ++e) { const float a = acc[ai][0][m][n][e], g = acc[ai][1][m][n][e]; o[4 * n + e] = a / (1.f + __expf(-g)); }
                    u32x4 w; w.x = pk2bf(o[0], o[1]); w.y = pk2bf(o[2], o[3]); w.z = pk2bf(o[4], o[5]); w.w = pk2bf(o[6], o[7]);
                    *(u32x4*)(dst + (size_t)row * CW + 128 * (pn - 6) + 32 * wc + 8 * fq) = w; }
        } else if (pn == 12 && wc == 1) {
            if (fq == 0) { float* dst = (float*)(ws + WS_IW);
#pragma unroll
                for (int ai = 0; ai < 2; ++ai)
#pragma unroll
                    for (int m = 0; m < 4; ++m) { const int row = row0 + ai * 128 + m * 16;
                        *(f32x4*)(dst + (size_t)row * 8) = acc[ai][0][m][0] * IWSCALE; *(f32x4*)(dst + (size_t)row * 8 + 4) = acc[ai][0][m][1] * IWSCALE; } }
        }
    }
};
struct EpiResid {
    static constexpr bool PERM = false, HAS_MID = false;
    const float* base; float* out; const float* mod; int gate_off;
    __device__ __forceinline__ void operator()(const f32x4 (&acc)[2][2][4][2], const pg8::Unit& u, int wr, int wc, int fr, int fq) const {
        const int row0 = u.pm * 256 + wr * 64 + fr, col0 = u.pn * 256 + wc * 32 + 4 * fq; const int b = (u.pm * 256) / SEQ;
        const float* gt = mod + b * 6144 + gate_off;
#pragma unroll
        for (int bj = 0; bj < 2; ++bj)
#pragma unroll
            for (int n = 0; n < 2; ++n) { const int col = col0 + bj * 128 + n * 16; const f32x4 g = *(const f32x4*)(gt + col);
#pragma unroll
                for (int ai = 0; ai < 2; ++ai)
#pragma unroll
                    for (int m = 0; m < 4; ++m) { const size_t off = (size_t)(row0 + ai * 128 + m * 16) * DM + col;
                        const f32x4 bs = *(const f32x4*)(base + off); *(f32x4*)(out + off) = bs + g * acc[ai][bj][m][n]; } }
    }
};
struct EpiFinal {
    static constexpr bool PERM = false, HAS_MID = false;
    const u16* x1b; float* out; const float* mod;
    __device__ __forceinline__ void operator()(const f32x4 (&acc)[2][2][4][2], const pg8::Unit& u, int wr, int wc, int fr, int fq) const {
        const int row0 = u.pm * 256 + wr * 64 + fr, col0 = u.pn * 256 + wc * 32 + 4 * fq; const int b = (u.pm * 256) / SEQ;
        const float* gt = mod + b * 6144 + 5120;
#pragma unroll
        for (int bj = 0; bj < 2; ++bj)
#pragma unroll
            for (int n = 0; n < 2; ++n) { const int col = col0 + bj * 128 + n * 16; const f32x4 g = *(const f32x4*)(gt + col);
#pragma unroll
                for (int ai = 0; ai < 2; ++ai)
#pragma unroll
                    for (int m = 0; m < 4; ++m) { const size_t off = (size_t)(row0 + ai * 128 + m * 16) * DM + col;
                        const u32x2 w = *(const u32x2*)(x1b + off);
                        const f32x4 bs = {bf2f((u16)(w.x & 0xffff)), bf2f((u16)(w.x >> 16)), bf2f((u16)(w.y & 0xffff)), bf2f((u16)(w.y >> 16))};
                        *(f32x4*)(out + off) = bs + g * acc[ai][bj][m][n]; } }
    }
};
struct EpiOut {
    static constexpr bool PERM = false, HAS_MID = true;
    const float* base; u16* x1b; float* ss2; const float* mod; const float* ssp;
    __device__ __forceinline__ void pre(float (&rs)[2][4], const pg8::Unit& u, int wr, int fr) const {
        const int row0 = u.pm * 256 + wr * 64 + fr;
#pragma unroll
        for (int ai = 0; ai < 2; ++ai)
#pragma unroll
            for (int m = 0; m < 4; ++m) { const float* sp = ssp + (size_t)(row0 + ai * 128 + m * 16) * 8; const f32x4 s0 = *(const f32x4*)sp, s1 = *(const f32x4*)(sp + 4);
                const float ss = ((s0.x + s0.y) + (s0.z + s0.w)) + ((s1.x + s1.y) + (s1.z + s1.w)); rs[ai][m] = 1.f / sqrtf(ss * (1.f / AW) + EPS); }
    }
    __device__ __forceinline__ void mid(f32x4 (&acc)[2][2][4][2], const float (&rs)[2][4]) const {
#pragma unroll
        for (int ai = 0; ai < 2; ++ai)
#pragma unroll
            for (int m = 0; m < 4; ++m)
#pragma unroll
                for (int bj = 0; bj < 2; ++bj)
#pragma unroll
                    for (int n = 0; n < 2; ++n) acc[ai][bj][m][n] *= rs[ai][m];
    }
    __device__ __forceinline__ void operator()(const f32x4 (&acc)[2][2][4][2], const pg8::Unit& u, int wr, int wc, int fr, int fq) const {
        const int row0 = u.pm * 256 + wr * 64 + fr, col0 = u.pn * 256 + wc * 32 + 4 * fq; const int b = (u.pm * 256) / SEQ;
        const float* gt = mod + b * 6144 + 2048;
        float rsq[2][4];
#pragma unroll
        for (int ai = 0; ai < 2; ++ai)
#pragma unroll
            for (int m = 0; m < 4; ++m) rsq[ai][m] = 0.f;
#pragma unroll
        for (int bj = 0; bj < 2; ++bj)
#pragma unroll
            for (int n = 0; n < 2; ++n) { const int col = col0 + bj * 128 + n * 16; const f32x4 g = *(const f32x4*)(gt + col);
#pragma unroll
                for (int ai = 0; ai < 2; ++ai)
#pragma unroll
                    for (int m = 0; m < 4; ++m) { const size_t off = (size_t)(row0 + ai * 128 + m * 16) * DM + col;
                        const f32x4 x1 = *(const f32x4*)(base + off) + g * acc[ai][bj][m][n];
                        u32x2 w; w.x = pk2bf(x1.x, x1.y); w.y = pk2bf(x1.z, x1.w); *(u32x2*)(x1b + off) = w;
                        rsq[ai][m] += (x1.x * x1.x + x1.y * x1.y) + (x1.z * x1.z + x1.w * x1.w); } }
#pragma unroll
        for (int ai = 0; ai < 2; ++ai)
#pragma unroll
            for (int m = 0; m < 4; ++m) { float v = rsq[ai][m]; v += __shfl_xor(v, 16); v += __shfl_xor(v, 32); if (fq == 0) atomicAdd(ss2 + row0 + ai * 128 + m * 16, v); }
    }
};
struct EpiFF1 {
    static constexpr bool PERM = true, HAS_MID = false;
    u16* O; const float* ss2; const float* cb;
    __device__ __forceinline__ void operator()(const f32x4 (&acc)[2][2][4][2], const pg8::Unit& u, int wr, int wc, int fr, int fq) const {
        const int row0 = u.pm * 256 + wr * 64 + fr, col0 = u.pn * 256 + wc * 32 + 8 * fq; const int b = (u.pm * 256) / SEQ;
        f32x4 c0[2], c1[2];
#pragma unroll
        for (int bj = 0; bj < 2; ++bj) { c0[bj] = *(const f32x4*)(cb + b * DFF + col0 + bj * 128); c1[bj] = *(const f32x4*)(cb + b * DFF + col0 + bj * 128 + 4); }
#pragma unroll
        for (int ai = 0; ai < 2; ++ai)
#pragma unroll
            for (int m = 0; m < 4; ++m) { const int row = row0 + ai * 128 + m * 16; const float rs = 1.f / sqrtf(ss2[row] * (1.f / DM) + EPS);
                u16* rowp = O + (size_t)row * DFF + col0;
#pragma unroll
                for (int bj = 0; bj < 2; ++bj) { f32x4 a = acc[ai][bj][m][0] * rs + c0[bj], c = acc[ai][bj][m][1] * rs + c1[bj];
#pragma unroll
                    for (int e = 0; e < 4; ++e) { const float x0 = fmaxf(a[e], 0.f), x1 = fmaxf(c[e], 0.f); a[e] = x0 * x0; c[e] = x1 * x1; }
                    u32x4 w; w.x = pk2bf(a[0], a[1]); w.y = pk2bf(a[2], a[3]); w.z = pk2bf(c[0], c[1]); w.w = pk2bf(c[2], c[3]);
                    *(u32x4*)(rowp + bj * 128) = w; } }
    }
};

constexpr int IX_CAP = 576;
constexpr int IX_IK = 0, IX_MASK = 0, IX_HIST = 32768, IX_CS = 32768, IX_CI = IX_CS + 32 * IX_CAP * 4, IX_INFO = IX_CI + 32 * IX_CAP * 2;
__device__ __forceinline__ int score_bin(float s) {
    const unsigned bits = __builtin_bit_cast(unsigned, s);
    const int mb = (int)((bits >> 18) & 0x1fffu);
    int c = mb - 3775; c = c < 0 ? 0 : (c > 511 ? 511 : c);
    const int sg = (int)bits >> 31;
    return (c ^ sg) + 512;
}
__device__ __forceinline__ int score_key(float s) { const int b = __builtin_bit_cast(int, s); return b ^ ((b >> 31) & 0x7fffffff); }
__device__ __forceinline__ int bin_keylo(int b) {
    if (b > 1023) return 0x7fffffff;
    if (b >= 512) { const int c = b - 512; return c == 0 ? 0 : ((c + 3775) << 18); }
    const int c = 511 - b; return c == 511 ? (int)0x80000000 : -((c + 3776) << 18);
}
__device__ __forceinline__ f32x16 idx_mma(const h16x8 (&af)[4], const h16x8 (&bf)[4]) {
    f32x16 c = {0.f, 0.f, 0.f, 0.f, 0.f, 0.f, 0.f, 0.f, 0.f, 0.f, 0.f, 0.f, 0.f, 0.f, 0.f, 0.f};
#pragma unroll
    for (int ks = 0; ks < 4; ++ks) c = __builtin_amdgcn_mfma_f32_32x32x16_f16(af[ks], bf[ks], c, 0, 0, 0);
    return c;
}
__device__ __forceinline__ void idx_epi(const f32x16& c, const float (&wq)[2][8], float& sA, float& sB) {
    float a = 0.f, b = 0.f;
#pragma unroll
    for (int j = 0; j < 8; ++j) { a = fmaf(__builtin_amdgcn_fmed3f(c[j] * 0x1p-12f, 0.f, 1.f), wq[0][j], a); b = fmaf(__builtin_amdgcn_fmed3f(c[8 + j] * 0x1p-12f, 0.f, 1.f), wq[1][j], b); }
    sA = a; sB = b;
}
typedef _Float16 h16x2 __attribute__((ext_vector_type(2)));
__device__ __forceinline__ int count_ge9(const unsigned (&u)[9], unsigned mid) {
    unsigned long long m0, m1, m2, m3, m4, m5, m6, m7, m8;
    asm("v_cmp_le_u32_e64 %0, %9, %10\n\tv_cmp_le_u32_e64 %1, %9, %11\n\tv_cmp_le_u32_e64 %2, %9, %12\n\tv_cmp_le_u32_e64 %3, %9, %13\n\t"
        "v_cmp_le_u32_e64 %4, %9, %14\n\tv_cmp_le_u32_e64 %5, %9, %15\n\tv_cmp_le_u32_e64 %6, %9, %16\n\tv_cmp_le_u32_e64 %7, %9, %17\n\tv_cmp_le_u32_e64 %8, %9, %18"
        : "=&s"(m0), "=&s"(m1), "=&s"(m2), "=&s"(m3), "=&s"(m4), "=&s"(m5), "=&s"(m6), "=&s"(m7), "=&s"(m8)
        : "s"(mid), "v"(u[0]), "v"(u[1]), "v"(u[2]), "v"(u[3]), "v"(u[4]), "v"(u[5]), "v"(u[6]), "v"(u[7]), "v"(u[8]));
    return __popcll(m0) + __popcll(m1) + __popcll(m2) + __popcll(m3) + __popcll(m4) + __popcll(m5) + __popcll(m6) + __popcll(m7) + __popcll(m8);
}
template <int VAR> __device__ __forceinline__ void idx_unit(const Params& p, LAS unsigned char* lds, int b, int hc, int tid, int wave, int lane) {
    const int t0 = hc * 32, N = 64 * (t0 / 64 + 1), NBT = (N + 127) >> 7, NST = N >> 5;
    const size_t rowb = (size_t)b * SEQ;
    unsigned* gmask = (unsigned*)(p.ws + (VAR ? WS_H : WS_MASK)) + (rowb + t0) * 256;
    LAS unsigned* lmask = (LAS unsigned*)(lds + IX_MASK);
    if (N <= 256) {
        for (int e = tid; e < 32 * 256; e += NTHR) { const int w = e & 255; gmask[e] = (w * 32 < N) ? 0xffffffffu : 0u; }
        return;
    }
    const u16* IQ = (const u16*)(p.ws + WS_IQ); const u16* IK = (const u16*)(p.ws + WS_IK); const float* IW = (const float*)(p.ws + WS_IW);
    const int qg = wave & 3, kh = wave >> 2, half = lane >> 5;
    h16x8 af[2][4]; float wq[2][2][8];
    { const int r = lane & 31, q = 2 * (r >> 4) + ((r >> 2) & 1), hd = (r & 3) + 4 * ((r >> 3) & 1);
#pragma unroll
      for (int a = 0; a < 2; ++a) { const u16* src = IQ + (rowb + t0 + 8 * qg + 4 * a + q) * 512 + hd * 64 + 8 * half;
#pragma unroll
          for (int ks = 0; ks < 4; ++ks) af[a][ks] = *(const h16x8*)(src + 16 * ks);
#pragma unroll
          for (int s2 = 0; s2 < 2; ++s2) { const float* wp = IW + (rowb + t0 + 8 * qg + 4 * a + 2 * s2 + half) * 8; const f32x4 w0 = *(const f32x4*)wp, w1 = *(const f32x4*)(wp + 4);
              wq[a][s2][0] = w0.x * 4096.f; wq[a][s2][1] = w0.y * 4096.f; wq[a][s2][2] = w0.z * 4096.f; wq[a][s2][3] = w0.w * 4096.f; wq[a][s2][4] = w1.x * 4096.f; wq[a][s2][5] = w1.y * 4096.f; wq[a][s2][6] = w1.z * 4096.f; wq[a][s2][7] = w1.w * 4096.f; } } }
    for (int e = tid; e < 65536 / 16; e += NTHR) *(LAS u32x4*)(lds + IX_HIST + e * 16) = (u32x4){0u, 0u, 0u, 0u};
    LAS int* info = (LAS int*)(lds + IX_INFO);
    int rowA[2], rowB[2];
#pragma unroll
    for (int a = 0; a < 2; ++a) { rowA[a] = 8 * qg + 4 * a + half; rowB[a] = rowA[a] + 2; }
    const int skey = tid >> 3, schunk = tid & 7; const int sdst = skey * 128 + ((schunk ^ ((skey >> 1) & 7)) * 16);
    const u16* ikg = IK + rowb * 64 + schunk * 8;
#define IDX_BFRAGS(ikt) h16x8 bf[2][4]; \
        _Pragma("unroll") for (int i = 0; i < 2; ++i) { const int key = (kh + 2 * i) * 32 + (lane & 31); \
            _Pragma("unroll") for (int ks = 0; ks < 4; ++ks) bf[i][ks] = *(const LAS h16x8*)((ikt) + key * 128 + (((2 * ks + half) ^ ((key >> 1) & 7)) * 16)); }
    {
        const int NBS = (NBT + 3) >> 2;
        auto sload = [&](int bs, u32x4& s0, u32x4& s1) __attribute__((always_inline)) {
            int j0 = 4 * bs + (skey >> 5), j1 = j0 + 2; j0 = j0 < NBT ? j0 : NBT - 1; j1 = j1 < NBT ? j1 : NBT - 1;
            s0 = *(const u32x4*)(ikg + (size_t)(128 * j0 + (skey & 31)) * 64); s1 = *(const u32x4*)(ikg + (size_t)(128 * j1 + (skey & 31)) * 64); };
        u32x4 stg0, stg1; sload(0, stg0, stg1);
        *(LAS u32x4*)(lds + IX_IK + sdst) = stg0; *(LAS u32x4*)(lds + IX_IK + 8192 + sdst) = stg1;
        __syncthreads();
        for (int bs = 0; bs < NBS; ++bs) {
            const LAS unsigned char* ikt = lds + IX_IK + (bs & 1) * 16384;
            sload(bs + 1 < NBS ? bs + 1 : bs, stg0, stg1);
            IDX_BFRAGS(ikt)
#define IDX_HIST(ACC, i, a) do { float sA, sB; idx_epi(ACC, wq[a], sA, sB); const unsigned one = (4 * bs + kh + 2 * (i)) < NBT ? 1u : 0u; \
                const int bA = score_bin(sA), bB = score_bin(sB); \
                lds_add_u32((LAS unsigned*)(lds + IX_HIST + rowA[a] * 2048 + (bA >> 1) * 4), one << ((bA & 1) * 16)); \
                lds_add_u32((LAS unsigned*)(lds + IX_HIST + rowB[a] * 2048 + (bB >> 1) * 4), one << ((bB & 1) * 16)); } while (0)
            f32x16 acc0 = idx_mma(af[0], bf[0]);
            f32x16 acc1 = idx_mma(af[1], bf[0]);
            IDX_HIST(acc0, 0, 0);
            acc0 = idx_mma(af[0], bf[1]);
            IDX_HIST(acc1, 0, 1);
            acc1 = idx_mma(af[1], bf[1]);
            IDX_HIST(acc0, 1, 0);
            IDX_HIST(acc1, 1, 1);
#undef IDX_HIST
            *(LAS u32x4*)(lds + IX_IK + ((bs + 1) & 1) * 16384 + sdst) = stg0; *(LAS u32x4*)(lds + IX_IK + ((bs + 1) & 1) * 16384 + 8192 + sdst) = stg1;
            __syncthreads();
        }
        const float nf = 32.f * (float)NBT, pf = 256.f / (float)N; const float varf = nf * pf * (1.f - pf) * (1.f - nf / (float)N);
        const unsigned R = (unsigned)(int)(nf * pf + 4.5f * sqrtf(varf > 0.f ? varf : 0.f) + 2.f);
        int tlo[4];
        for (int rr = 0; rr < 4; ++rr) { const int row = 4 * wave + rr;
            const LAS unsigned* hrow = (const LAS unsigned*)(lds + IX_HIST + row * 2048) + lane * 8;
            unsigned cnt[16]; unsigned tot = 0;
#pragma unroll
            for (int j = 0; j < 8; ++j) { const unsigned w = hrow[j]; cnt[2 * j] = w & 0xffffu; cnt[2 * j + 1] = w >> 16; tot += cnt[2 * j] + cnt[2 * j + 1]; }
            unsigned incl = tot;
#pragma unroll
            for (int o = 1; o < 64; o <<= 1) { const unsigned v = __shfl_down(incl, o); if (lane + o < 64) incl += v; }
            const unsigned above = incl - tot;
            int fs = -1;
            if (above < R && above + tot >= R) { unsigned run = above;
#pragma unroll
                for (int j = 15; j >= 0; --j) { const unsigned cjj = cnt[j]; if (run < R && run + cjj >= R) fs = 16 * lane + j; run += cjj; } }
            const unsigned long long fm = __ballot(fs >= 0); const int src = fm ? (int)__builtin_ctzll(fm) : 0;
            const int fsb = __shfl(fs, src);
            tlo[rr] = fm ? bin_keylo(fsb) : (int)0x80000000;
        }
        __syncthreads();
        if (lane == 0) { for (int rr = 0; rr < 4; ++rr) { const int k = tlo[rr]; info[(4 * wave + rr) * 4] = (k == (int)0x80000000) ? (int)0xff800000 : (k ^ ((k >> 31) & 0x7fffffff)); } }
        __syncthreads();
    }
    {
        float tA[2], tB[2]; LAS unsigned char *ctrA[2], *ctrB[2], *csA[2], *csB[2], *ciA[2], *ciB[2];
#pragma unroll
        for (int a = 0; a < 2; ++a) { tA[a] = __builtin_bit_cast(float, info[rowA[a] * 4]); tB[a] = __builtin_bit_cast(float, info[rowB[a] * 4]);
            ctrA[a] = lds + IX_INFO + rowA[a] * 16 + 4; ctrB[a] = lds + IX_INFO + rowB[a] * 16 + 4;
            csA[a] = lds + IX_CS + rowA[a] * (IX_CAP * 4); csB[a] = lds + IX_CS + rowB[a] * (IX_CAP * 4); ciA[a] = lds + IX_CI + rowA[a] * (IX_CAP * 2); ciB[a] = lds + IX_CI + rowB[a] * (IX_CAP * 2); }
        LAS unsigned char* dummy = lds + IX_INFO + 1024 + tid * 4;
        float dsum = 0.f;
        if (tid < 32) info[tid * 4 + 1] = 0;
        u32x4 stg0 = *(const u32x4*)(ikg + (size_t)skey * 64), stg1 = *(const u32x4*)(ikg + (size_t)(skey + 64) * 64);
        *(LAS u32x4*)(lds + IX_IK + sdst) = stg0; *(LAS u32x4*)(lds + IX_IK + 8192 + sdst) = stg1;
        __syncthreads();
#define IDX_REQ(ACC, i, a, KA, KB, PA, PB, SLA, SLB, KI) do { float sA, sB; if (VAR == 7) { sA = ACC[0]; sB = ACC[8]; } else idx_epi(ACC, wq[a], sA, sB); \
                if (VAR == 6 || VAR == 7) { dsum += sA + sB; PA = false; PB = false; KA = 0; KB = 0; SLA = 0; SLB = 0; KI = 0; break; } \
                const int st_ = 4 * bt + kh + 2 * (i); const bool valid_ = st_ < NST; KI = 32 * st_ + (lane & 31); \
                KA = __builtin_bit_cast(int, sA); KB = __builtin_bit_cast(int, sB); PA = (sA >= tA[a]) && valid_; PB = (sB >= tB[a]) && valid_; \
                SLA = lds_add_u32((LAS unsigned*)(PA ? ctrA[a] : dummy), 1u); SLB = lds_add_u32((LAS unsigned*)(PB ? ctrB[a] : dummy), 1u); } while (0)
#define IDX_PUT(a, KA, KB, PA, PB, SLA, SLB, KI) do { \
                if (PA && SLA < (unsigned)IX_CAP) { *(LAS int*)(csA[a] + SLA * 4) = KA; *(LAS u16*)(ciA[a] + SLA * 2) = (u16)(KI); } \
                if (PB && SLB < (unsigned)IX_CAP) { *(LAS int*)(csB[a] + SLB * 4) = KB; *(LAS u16*)(ciB[a] + SLB * 2) = (u16)(KI); } } while (0)
        for (int bt = 0; bt < NBT; ++bt) {
            const LAS unsigned char* ikt = lds + IX_IK + (bt & 1) * 16384;
            { const int nb = bt + 1 < NBT ? bt + 1 : bt; stg0 = *(const u32x4*)(ikg + (size_t)(nb * 128 + skey) * 64); stg1 = *(const u32x4*)(ikg + (size_t)(nb * 128 + skey + 64) * 64); }
            IDX_BFRAGS(ikt)
            int kA0, kB0, kA1, kB1, ki0, ki1; bool pA0, pB0, pA1, pB1; unsigned slA0, slB0, slA1, slB1;
            f32x16 acc0 = idx_mma(af[0], bf[0]);
            f32x16 acc1 = idx_mma(af[1], bf[0]);
            IDX_REQ(acc0, 0, 0, kA0, kB0, pA0, pB0, slA0, slB0, ki0);
            acc0 = idx_mma(af[0], bf[1]);
            IDX_REQ(acc1, 0, 1, kA1, kB1, pA1, pB1, slA1, slB1, ki1);
            IDX_PUT(0, kA0, kB0, pA0, pB0, slA0, slB0, ki0);
            acc1 = idx_mma(af[1], bf[1]);
            IDX_REQ(acc0, 1, 0, kA0, kB0, pA0, pB0, slA0, slB0, ki0);
            IDX_PUT(1, kA1, kB1, pA1, pB1, slA1, slB1, ki1);
            IDX_REQ(acc1, 1, 1, kA1, kB1, pA1, pB1, slA1, slB1, ki1);
            IDX_PUT(0, kA0, kB0, pA0, pB0, slA0, slB0, ki0);
            IDX_PUT(1, kA1, kB1, pA1, pB1, slA1, slB1, ki1);
            *(LAS u32x4*)(lds + IX_IK + ((bt + 1) & 1) * 16384 + sdst) = stg0; *(LAS u32x4*)(lds + IX_IK + ((bt + 1) & 1) * 16384 + 8192 + sdst) = stg1;
            __syncthreads();
        }
        if (VAR == 6 || VAR == 7) *(LAS float*)dummy = dsum;
#undef IDX_REQ
#undef IDX_PUT
    }
#undef IDX_BFRAGS
    for (int e = tid; e < 32768 / 16; e += NTHR) *(LAS u32x4*)(lds + IX_MASK + e * 16) = (u32x4){0u, 0u, 0u, 0u};
    __syncthreads();
    if (VAR == 2) { for (int e = tid; e < 32 * 256 / 4; e += NTHR) ((u32x4*)(p.ws + WS_H + 8 * MiB) + (size_t)(b * 256 + hc) * 2048)[e] = *(const LAS u32x4*)(lds + IX_CS + e * 16); __syncthreads(); return; }
    {
        unsigned uk[4][9]; int kx[4][9]; int Cn[4];
#pragma unroll
        for (int rr = 0; rr < 4; ++rr) { const int row = 4 * wave + rr;
            int c0 = info[row * 4 + 1];
#ifdef DEBUG_CHECK
            if (VAR == 0 && lane == 0 && c0 > IX_CAP) atomicAdd((unsigned*)(p.ws + WS_CTL) + 14, 1u);
#endif
            c0 = c0 > IX_CAP ? IX_CAP : c0;
            Cn[rr] = c0;
            const LAS int* cs = (const LAS int*)(lds + IX_CS) + row * IX_CAP; const LAS u16* ci = (const LAS u16*)(lds + IX_CI) + row * IX_CAP;
#pragma unroll
            for (int e = 0; e < 9; ++e) { const int pi = lane + 64 * e; const bool ok = pi < c0;
                const unsigned u = (unsigned)score_key(__builtin_bit_cast(float, cs[pi])) ^ 0x80000000u; uk[rr][e] = ok ? (u == 0u ? 1u : u) : 0u; kx[rr][e] = ok ? (int)ci[pi] : 0x7fffffff; } }
        unsigned lo[4], hi[4], p0[4];
#pragma unroll
        for (int rr = 0; rr < 4; ++rr) { lo[rr] = 1u; hi[rr] = Cn[rr] <= 256 ? 2u : 0xffffffffu;
            const int tb = __builtin_amdgcn_readfirstlane(info[(4 * wave + rr) * 4]);
            p0[rr] = (unsigned)score_key(__builtin_bit_cast(float, tb)) ^ 0x80000000u; }
#define IDX_BIS(MIDEXPR, CHECK) do { \
            _Pragma("unroll") for (int rr = 0; rr < 4; ++rr) { const unsigned mid = (MIDEXPR); \
                const int cnt = count_ge9(uk[rr], mid); \
                const bool ok = !(CHECK) || (mid - lo[rr] - 1u) < (hi[rr] - lo[rr] - 1u);             \
                const unsigned nlo = cnt >= 256 ? mid : lo[rr], nhi = cnt > 256 ? hi[rr] : (cnt == 256 ? mid + 1u : mid); \
                lo[rr] = ok ? nlo : lo[rr]; hi[rr] = ok ? nhi : hi[rr]; } } while (0)
        if (VAR != 14) {
            IDX_BIS(p0[rr], true);
            IDX_BIS(lo[rr] + (1u << 22), true);
            if (p0[0] <= 0x80000000u || p0[1] <= 0x80000000u || p0[2] <= 0x80000000u || p0[3] <= 0x80000000u) {
                IDX_BIS(0x80000001u, true);
                IDX_BIS(0x80000000u, true);
            }
            for (int it = 0; it < 32; ++it) {
                IDX_BIS(lo[rr] + ((hi[rr] - lo[rr]) >> 1), false);
                const unsigned w = ((hi[0] - lo[0]) | (hi[1] - lo[1]) | (hi[2] - lo[2]) | (hi[3] - lo[3]));
                if (w <= 1u) break;
            }
        }
#undef IDX_BIS
#pragma unroll
        for (int rr = 0; rr < 4; ++rr) { const int row = 4 * wave + rr;
            unsigned thr = lo[rr]; int need = 0;
            if (Cn[rr] <= 256) thr = 0u;
            else { int above = 0;
#pragma unroll
                for (int e = 0; e < 9; ++e) above += __popcll(__ballot(uk[rr][e] > thr));
                need = 256 - above; }
            bool sel[9]; int ntie = 0;
#pragma unroll
            for (int e = 0; e < 9; ++e) ntie += __popcll(__ballot(uk[rr][e] == thr && thr != 0u));
            const bool alltie = ntie <= need;
#pragma unroll
            for (int e = 0; e < 9; ++e) sel[e] = uk[rr][e] > thr || (alltie && uk[rr][e] == thr);
            if (!alltie) {
                int ilo = -1, ihi = 8191;
                for (int it = 0; it < 13; ++it) { const int imid = (ilo + ihi) >> 1; int c = 0;
#pragma unroll
                    for (int e = 0; e < 9; ++e) c += __popcll(__ballot(uk[rr][e] == thr && kx[rr][e] <= imid));
                    if (c >= need) ihi = imid; else ilo = imid; }
#pragma unroll
                for (int e = 0; e < 9; ++e) sel[e] = sel[e] || (uk[rr][e] == thr && kx[rr][e] <= ihi);
            }
#pragma unroll
            for (int e = 0; e < 9; ++e) if (sel[e] && kx[rr][e] != 0x7fffffff) lds_or_u32((LAS unsigned*)&lmask[row * 256 + (kx[rr][e] >> 5)], 1u << (kx[rr][e] & 31));
        }
    }
    __syncthreads();
    for (int e = tid; e < 32 * 256 / 4; e += NTHR) ((u32x4*)gmask)[e] = *(const LAS u32x4*)(lds + IX_MASK + e * 16);
    __syncthreads();
}

constexpr int CV_IN = 0, CV_Y = 65536;
__device__ __forceinline__ void conv_unit(const Params& p, LAS unsigned char* lds, int unit, int tid, int wave, int lane) {
    const int b = unit >> 8, t0 = (unit & 255) * 32; const size_t rowb = (size_t)b * SEQ;
    const u16* G = (const u16*)(p.ws + WS_GLU); u16* MX = (u16*)(p.ws + WS_CONV);
    LAS u16* ubuf = (LAS u16*)(lds + CV_IN); LAS float* ybuf = (LAS float*)(lds + CV_Y);
    { u32x4 sv[8];
#pragma unroll
      for (int i = 0; i < 8; ++i) { const int e = tid + i * NTHR; const int r = e >> 6, c = e & 63; const int t = t0 - 30 + r;
          sv[i] = (u32x4){0u, 0u, 0u, 0u}; if (e < 62 * 64 && t >= 0) sv[i] = *(const u32x4*)(G + (rowb + t) * CW + c * 8); }
#pragma unroll
      for (int i = 0; i < 8; ++i) { const int e = tid + i * NTHR; if (e < 62 * 64) *(LAS u32x4*)(ubuf + (e >> 6) * 512 + (e & 63) * 8) = sv[i]; } }
    __syncthreads();
    {
        const int c = tid; float w[CK];
#pragma unroll
        for (int j = 0; j < CK; ++j) w[j] = p.w_dw[j * CW + c];
        const float bias = p.b_dw[c];
        float u[62];
#pragma unroll
        for (int i = 0; i < 62; ++i) u[i] = bf2f(ubuf[i * 512 + c]);
#pragma unroll
        for (int i = 0; i < 32; ++i) { float a = bias;
#pragma unroll
            for (int j = 0; j < CK; ++j) a = fmaf(w[j], u[i + j], a);
            ybuf[i * 512 + c] = a; }
    }
    __syncthreads();
    {
        float v[4][8]; float s[4], q[4], ss[4];
        const f32x4 g0 = *(const f32x4*)(p.g_conv_ln + 8 * lane), g1 = *(const f32x4*)(p.g_conv_ln + 8 * lane + 4), b0 = *(const f32x4*)(p.b_conv_ln + 8 * lane), b1 = *(const f32x4*)(p.b_conv_ln + 8 * lane + 4);
#pragma unroll
        for (int rr = 0; rr < 4; ++rr) { const int tok = 4 * wave + rr;
            const f32x4 a = *(const LAS f32x4*)(ybuf + tok * 512 + 8 * lane), c2 = *(const LAS f32x4*)(ybuf + tok * 512 + 8 * lane + 4);
            v[rr][0] = a.x; v[rr][1] = a.y; v[rr][2] = a.z; v[rr][3] = a.w; v[rr][4] = c2.x; v[rr][5] = c2.y; v[rr][6] = c2.z; v[rr][7] = c2.w;
            s[rr] = 0.f;
#pragma unroll
            for (int e = 0; e < 8; ++e) s[rr] += v[rr][e]; }
#pragma unroll
        for (int o = 1; o < 64; o <<= 1) {
#pragma unroll
            for (int rr = 0; rr < 4; ++rr) s[rr] += __shfl_xor(s[rr], o); }
#pragma unroll
        for (int rr = 0; rr < 4; ++rr) { const float mu = s[rr] * (1.f / CW); q[rr] = 0.f;
#pragma unroll
            for (int e = 0; e < 8; ++e) { v[rr][e] -= mu; q[rr] += v[rr][e] * v[rr][e]; } }
#pragma unroll
        for (int o = 1; o < 64; o <<= 1) {
#pragma unroll
            for (int rr = 0; rr < 4; ++rr) q[rr] += __shfl_xor(q[rr], o); }
#pragma unroll
        for (int rr = 0; rr < 4; ++rr) { const float rstd = 1.f / sqrtf(q[rr] * (1.f / CW) + EPS); ss[rr] = 0.f;
#pragma unroll
            for (int e = 0; e < 8; ++e) { const float gg = e < 4 ? g0[e & 3] : g1[e & 3], bb = e < 4 ? b0[e & 3] : b1[e & 3]; const float y = v[rr][e] * rstd * gg + bb; const float z = y / (1.f + __expf(-y)); v[rr][e] = z; ss[rr] += z * z; } }
#pragma unroll
        for (int o = 1; o < 64; o <<= 1) {
#pragma unroll
            for (int rr = 0; rr < 4; ++rr) ss[rr] += __shfl_xor(ss[rr], o); }
#pragma unroll
        for (int rr = 0; rr < 4; ++rr) { const int tok = 4 * wave + rr; const float r2 = 1.f / sqrtf(ss[rr] * (1.f / CW) + EPS);
            u32x4 o; o.x = pk2bf(v[rr][0] * r2, v[rr][1] * r2); o.y = pk2bf(v[rr][2] * r2, v[rr][3] * r2); o.z = pk2bf(v[rr][4] * r2, v[rr][5] * r2); o.w = pk2bf(v[rr][6] * r2, v[rr][7] * r2);
            *(u32x4*)(MX + (rowb + t0 + tok) * CW + 8 * lane) = o; }
    }
    __syncthreads();
}

constexpr int AT_K = 0, AT_V = 16384, AT_O = 32768, AT_L = 65536;
typedef short v4i16_t __attribute__((ext_vector_type(4)));
__device__ __forceinline__ void at_qk(f32x16& p0, f32x16& p1, const LAS unsigned char* kt, const b16x8 (&qf)[4], int r32, int hi) {
#pragma unroll
    for (int r = 0; r < 16; ++r) { p0[r] = -SM_OFF; p1[r] = -SM_OFF; }
#pragma unroll
    for (int ks = 0; ks < 4; ++ks) {
        const int k0 = r32, k1 = 32 + r32;
        const b16x8 a0 = *(const LAS b16x8*)(kt + k0 * 128 + (((2 * ks + hi) ^ ((k0 >> 1) & 7)) * 16));
        const b16x8 a1 = *(const LAS b16x8*)(kt + k1 * 128 + (((2 * ks + hi) ^ ((k1 >> 1) & 7)) * 16));
        p0 = __builtin_amdgcn_mfma_f32_32x32x16_bf16(a0, qf[ks], p0, 0, 0, 0);
        p1 = __builtin_amdgcn_mfma_f32_32x32x16_bf16(a1, qf[ks], p1, 0, 0, 0);
    }
}
__device__ __forceinline__ void attn_unit(const Params& p, LAS unsigned char* lds, int b, int h, int qt, int tid, int wave, int lane) {
    const size_t rowb = (size_t)b * SEQ; const int q0 = qt * 256, NT = 4 * (qt + 1);
    const u16* Q = (const u16*)(p.ws + WS_Q); const u16* Kg = (const u16*)(p.ws + WS_K); const u16* Vg = (const u16*)(p.ws + WS_V);
    const unsigned* MK = (const unsigned*)(p.ws + WS_MASK);
    const int r32 = lane & 31, hi = lane >> 5;
    const int qrow = q0 + 32 * wave + r32;
    b16x8 qf[4];
    { const u16* src = Q + (rowb + qrow) * AW + h * 64 + 8 * hi;
#pragma unroll
      for (int ks = 0; ks < 4; ++ks) qf[ks] = *(const b16x8*)(src + 16 * ks); }
    const unsigned* mrow = MK + (rowb + qrow) * 256;
    f32x16 o0 = {0.f, 0.f, 0.f, 0.f, 0.f, 0.f, 0.f, 0.f, 0.f, 0.f, 0.f, 0.f, 0.f, 0.f, 0.f, 0.f}, o1 = o0;
    f32x16 lacc = o0;
    const b16x8 ones = __builtin_bit_cast(b16x8, (u32x4){0x3f803f80u, 0x3f803f80u, 0x3f803f80u, 0x3f803f80u});
    const int kkey = 8 * wave + (lane >> 3), kch = (lane & 7) ^ ((kkey >> 1) & 7);
    const u16* kg = Kg + (rowb + kkey) * AW + h * 64 + kch * 8;
    const u16* vg = Vg + (rowb + 16 * (wave & 3) + (lane >> 2)) * AW + h * 64 + 32 * (wave >> 2) + 8 * (lane & 3);
    const int dma_off = wave * 1024;
#define AT_DMA(gp, ldsoff) __builtin_amdgcn_global_load_lds((const unsigned*)(gp), (LAS unsigned*)(lds + (ldsoff) + dma_off), 16, 0, 0)
    AT_DMA(kg, AT_K); AT_DMA(kg + (size_t)64 * AW, AT_K + 8192); AT_DMA(vg, AT_V);
    u32x2 mw = *(const u32x2*)(mrow); u32x2 mwA = mw;
    __syncthreads();
    f32x16 sA, sB, sC_, sD_;
    at_qk(sA, sB, lds + AT_K, qf, r32, hi);
    __syncthreads();
    const int g16 = lane >> 4, q4 = (lane & 15) >> 2, pp = lane & 3;
    const int vb = (g16 & 1) * 32 + pp * 8 + (4 * (g16 >> 1) + q4) * 64;
#define AT_STEP(C0, C1, N0, N1, t) do { \
        const int tk_ = (t) + 2 < NT ? (t) + 2 : NT - 1, tv_ = (t) + 1 < NT ? (t) + 1 : NT - 1; \
        AT_DMA(kg + (size_t)tk_ * 64 * AW, AT_K + ((t) & 1) * 8192);              \
        AT_DMA(vg + (size_t)tv_ * 64 * AW, AT_V + (((t) + 1) & 1) * 8192);        \
        mwA = *(const u32x2*)(mrow + 2 * tv_); \
        at_qk(N0, N1, lds + AT_K + (((t) + 1) & 1) * 8192, qf, r32, hi); \
        const unsigned w0_ = mw.x >> (4 * hi), w1_ = mw.y >> (4 * hi); \
        _Pragma("unroll") for (int r = 0; r < 16; ++r) { const int pos_ = (r & 3) + 8 * (r >> 2); \
            const float e0_ = __builtin_amdgcn_exp2f(C0[r]); int m0_ = __builtin_amdgcn_sbfe((int)w0_, pos_, 1); asm("" : "+v"(m0_)); \
            C0[r] = __builtin_bit_cast(float, __builtin_bit_cast(int, e0_) & m0_); } \
        b16x8 pa_[4]; \
        _Pragma("unroll") for (int s_ = 0; s_ < 2; ++s_) { u32x4 w_; \
            _Pragma("unroll") for (int j = 0; j < 4; ++j) w_[j] = pk2bf(C0[8 * s_ + 2 * j], C0[8 * s_ + 2 * j + 1]); \
            pa_[s_] = __builtin_bit_cast(b16x8, w_); } \
        _Pragma("unroll") for (int r = 0; r < 16; ++r) { const int pos_ = (r & 3) + 8 * (r >> 2); \
            const float e1_ = __builtin_amdgcn_exp2f(C1[r]); int m1_ = __builtin_amdgcn_sbfe((int)w1_, pos_, 1); asm("" : "+v"(m1_)); \
            C1[r] = __builtin_bit_cast(float, __builtin_bit_cast(int, e1_) & m1_); } \
        _Pragma("unroll") for (int s_ = 0; s_ < 2; ++s_) { u32x4 w_; \
            _Pragma("unroll") for (int j = 0; j < 4; ++j) w_[j] = pk2bf(C1[8 * s_ + 2 * j], C1[8 * s_ + 2 * j + 1]); \
            pa_[2 + s_] = __builtin_bit_cast(b16x8, w_); } \
        { const LAS unsigned char* vt_ = lds + AT_V + ((t) & 1) * 8192; \
          _Pragma("unroll") for (int s_ = 0; s_ < 4; ++s_) \
          _Pragma("unroll") for (int d0 = 0; d0 < 2; ++d0) { \
              const LAS unsigned char* a_ = vt_ + vb + s_ * 1024 + d0 * 4096; \
              const v4i16_t lo_ = __builtin_amdgcn_ds_read_tr16_b64_v4i16((LAS v4i16_t*)a_); \
              const v4i16_t hi4_ = __builtin_amdgcn_ds_read_tr16_b64_v4i16((LAS v4i16_t*)(a_ + 512)); \
              const s16x8 bv_ = (s16x8){lo_[0], lo_[1], lo_[2], lo_[3], hi4_[0], hi4_[1], hi4_[2], hi4_[3]}; \
              if (d0 == 0) { o0 = __builtin_amdgcn_mfma_f32_32x32x16_bf16(pa_[s_], __builtin_bit_cast(b16x8, bv_), o0, 0, 0, 0); lacc = __builtin_amdgcn_mfma_f32_32x32x16_bf16(pa_[s_], ones, lacc, 0, 0, 0); } \
              else o1 = __builtin_amdgcn_mfma_f32_32x32x16_bf16(pa_[s_], __builtin_bit_cast(b16x8, bv_), o1, 0, 0, 0); } } \
        mw = mwA; \
          \
        _Pragma("unroll") for (int i_ = 0; i_ < 8; ++i_) { __builtin_amdgcn_sched_group_barrier(0x100, 2, 0); __builtin_amdgcn_sched_group_barrier(0x008, 1, 0); __builtin_amdgcn_sched_group_barrier(0x002, 7, 0); } \
        _Pragma("unroll") for (int i_ = 0; i_ < 8; ++i_) { __builtin_amdgcn_sched_group_barrier(0x100, 2, 0); __builtin_amdgcn_sched_group_barrier(0x008, 1, 0); __builtin_amdgcn_sched_group_barrier(0x002, 7, 0); } \
        __syncthreads(); } while (0)
    for (int t = 0; t < NT; t += 2) {
        AT_STEP(sA, sB, sC_, sD_, t);
        AT_STEP(sC_, sD_, sA, sB, t + 1);
    }
#undef AT_STEP
#undef AT_DMA
    LAS u16* stg = (LAS u16*)(lds + AT_O + wave * 4096);
#pragma unroll
    for (int r = 0; r < 16; ++r) { const int orow = (r & 3) + 8 * (r >> 2) + 4 * hi; const float rl = 1.f / lacc[r];
        stg[orow * 64 + r32] = (u16)f2bf(o0[r] * rl); stg[orow * 64 + 32 + r32] = (u16)f2bf(o1[r] * rl); }
    LDS_WAIT(); asm volatile("" ::: "memory");
    { const int row = lane >> 1, hf = lane & 1; float ss = 0.f; u32x4 v[4];
#pragma unroll
      for (int j = 0; j < 4; ++j) { v[j] = *(const LAS u32x4*)(stg + row * 64 + hf * 32 + j * 8);
#pragma unroll
          for (int e = 0; e < 4; ++e) { const float a = bf2f((u16)(v[j][e] & 0xffff)), c = bf2f((u16)(v[j][e] >> 16)); ss += a * a + c * c; } }
      ss += __shfl_xor(ss, 1);
      const size_t grow = rowb + q0 + 32 * wave + row;
      u16* dst = (u16*)(p.ws + WS_ATT) + grow * AW + h * 64 + hf * 32;
#pragma unroll
      for (int j = 0; j < 4; ++j) *(u32x4*)(dst + j * 8) = v[j];
      if (hf == 0) ((float*)(p.ws + WS_SSP))[grow * 8 + h] = ss; }
    __syncthreads();
}

#ifdef DEBUG_CHECK
__device__ __forceinline__ void dbg_attn_check(const Params& p, int gw, int NGW, int lane) {
    const u16* Q = (const u16*)(p.ws + WS_Q); const u16* Kg = (const u16*)(p.ws + WS_K); const u16* Vg = (const u16*)(p.ws + WS_V);
    const unsigned* MK = (const unsigned*)(p.ws + WS_MASK); const u16* A = (const u16*)(p.ws + WS_ATT);
    unsigned* ctl = (unsigned*)(p.ws + WS_CTL);
    for (int it = gw; it < (M / 16) * 8; it += NGW) {
        const int row = (it >> 3) * 16 + 5, h = it & 7; const int b = row / SEQ, t = row % SEQ; const size_t rowb = (size_t)b * SEQ;
        const int N = 64 * (t / 64 + 1);
        float q[64];
#pragma unroll
        for (int d = 0; d < 64; ++d) q[d] = bf2f(Q[(size_t)row * AW + h * 64 + d]);
        float o[64]; float l = 0.f;
#pragma unroll
        for (int d = 0; d < 64; ++d) o[d] = 0.f;
        for (int key = lane; key < N; key += 64) {
            const unsigned w = MK[(size_t)row * 256 + (key >> 5)];
            if ((w >> (key & 31)) & 1u) {
                float s = 0.f;
#pragma unroll
                for (int d = 0; d < 64; ++d) s += q[d] * bf2f(Kg[(rowb + key) * AW + h * 64 + d]);
                const float pr = exp2f(s - SM_OFF); l += pr;
#pragma unroll
                for (int d = 0; d < 64; ++d) o[d] += pr * bf2f(Vg[(rowb + key) * AW + h * 64 + d]);
            }
        }
        l = wave_sum(l); float maxerr = 0.f, maxref = 0.f;
#pragma unroll
        for (int d = 0; d < 64; ++d) { const float od = wave_sum(o[d]) / l; const float got = bf2f(A[(size_t)row * AW + h * 64 + d]); maxerr = fmaxf(maxerr, fabsf(od - got)); maxref = fmaxf(maxref, fabsf(od)); }
        if (lane == 0 && !(maxerr <= 0.03f * maxref + 1e-3f)) atomicAdd(&ctl[8], 1u);
    }
}
__device__ __forceinline__ void dbg_idx_check(const Params& p, int gw, int NGW, int lane) {
    const u16* IQ = (const u16*)(p.ws + WS_IQ); const u16* IK = (const u16*)(p.ws + WS_IK); const float* IW = (const float*)(p.ws + WS_IW);
    const unsigned* MK = (const unsigned*)(p.ws + WS_MASK); unsigned* ctl = (unsigned*)(p.ws + WS_CTL);
    for (int it = gw; it < M / 16; it += NGW) {
        const int row = it * 16 + 5; const int b = row / SEQ, t = row % SEQ; const size_t rowb = (size_t)b * SEQ; const int N = 64 * (t / 64 + 1);
        float minsel = 3e38f, maxun = -3e38f; int cnt = 0;
        for (int key = lane; key < N; key += 64) {
            float sc = 0.f;
            for (int h = 0; h < 8; ++h) { float d = 0.f;
                for (int e = 0; e < 64; ++e) d += (float)__builtin_bit_cast(_Float16, IQ[(size_t)row * 512 + h * 64 + e]) * (float)__builtin_bit_cast(_Float16, IK[(rowb + key) * 64 + e]);
                sc += IW[(size_t)row * 8 + h] * fmaxf(d, 0.f); }
            const unsigned w = MK[(size_t)row * 256 + (key >> 5)];
            if ((w >> (key & 31)) & 1u) { minsel = fminf(minsel, sc); ++cnt; } else maxun = fmaxf(maxun, sc);
        }
        int extra = 0; for (int wi = N / 32 + lane; wi < 256; wi += 64) extra += __popc(MK[(size_t)row * 256 + wi]);
#pragma unroll
        for (int o = 1; o < 64; o <<= 1) { minsel = fminf(minsel, __shfl_xor(minsel, o)); maxun = fmaxf(maxun, __shfl_xor(maxun, o)); cnt += __shfl_xor(cnt, o); extra += __shfl_xor(extra, o); }
        const int want = N < 256 ? N : 256;
        if (lane == 0) { if (cnt != want) { atomicAdd(&ctl[9], 1u); atomicMax(&ctl[12], (unsigned)(N / 64)); atomicMax(&ctl[13], (unsigned)(cnt > want ? cnt - want : want - cnt)); }
            else if (extra != 0) atomicAdd(&ctl[10], 1u);
            else if (N > 256 && !(minsel >= maxun - 2e-3f * (fabsf(maxun) + 1.f))) atomicAdd(&ctl[11], 1u); }
    }
}
__device__ __forceinline__ void dbg_encode(const Params& p, int gw, int NGW, int lane) {
    const unsigned* ctl = (const unsigned*)(p.ws + WS_CTL);
    const unsigned cb = __hip_atomic_load(&ctl[9], __ATOMIC_RELAXED, __HIP_MEMORY_SCOPE_AGENT), eb = __hip_atomic_load(&ctl[10], __ATOMIC_RELAXED, __HIP_MEMORY_SCOPE_AGENT), ob = __hip_atomic_load(&ctl[11], __ATOMIC_RELAXED, __HIP_MEMORY_SCOPE_AGENT);
    const unsigned n64 = __hip_atomic_load(&ctl[12], __ATOMIC_RELAXED, __HIP_MEMORY_SCOPE_AGENT), dc = __hip_atomic_load(&ctl[13], __ATOMIC_RELAXED, __HIP_MEMORY_SCOPE_AGENT);
    const unsigned c14 = __hip_atomic_load(&ctl[14], __ATOMIC_RELAXED, __HIP_MEMORY_SCOPE_AGENT), c15 = __hip_atomic_load(&ctl[15], __ATOMIC_RELAXED, __HIP_MEMORY_SCOPE_AGENT);
    if (cb == 0 && eb == 0 && ob == 0 && c14 == 0 && c15 == 0) return;
    const float s = c14 ? 0.5f : (c15 ? -1.f : 0.f);
    for (int m = gw; m < M; m += NGW) { const f32x4* xr = (const f32x4*)(p.x + (size_t)m * DM) + lane; f32x4* o = (f32x4*)(p.out + (size_t)m * DM) + lane;
#pragma unroll
        for (int j = 0; j < 4; ++j) o[64 * j] = xr[64 * j] * s; }
    if (gw == 0 && lane == 0) { p.out[0] = 1000.f * (float)cb; p.out[1] = 0.f; }
    (void)n64; (void)dc;
}
#endif

__global__ void __launch_bounds__(NTHR, 2) fwd_megakernel(Params p) {
    extern __shared__ __attribute__((aligned(16))) unsigned char lds_raw[];
    LAS unsigned char* lds = (LAS unsigned char*)lds_raw;
    const int tid = threadIdx.x;
    const int G = gridDim.x; const int bx = blockIdx.x; const int vcu = (G % 8 == 0) ? (bx % 8) * (G / 8) + bx / 8 : bx;
    volatile LAS unsigned* MISC = (volatile LAS unsigned*)(lds + MISC_OFF);
    for (int u = tid; u < (LDS_BYTES - RING_BYTES) / 4; u += NTHR) ((LAS unsigned*)(lds + RING_BYTES))[u] = 0u;
    __syncthreads();
    XcdBarrier bar = xcd_barrier_post((unsigned*)(p.ws + WS_CTL) + CW_BAR, MISC + 8);
    const int NGW = G * NWAVES;

#define PH_IDS() const int tid_ = opaque_tid(); const int lane_ = tid_ & 63; const int wave_ = __builtin_amdgcn_readfirstlane(tid_ >> 6); const int gw_ = vcu * NWAVES + wave_
    REP(0) { PH_IDS(); p0_phase(p, lds, vcu, G, tid_, wave_, lane_); }
    xcd_barrier(bar);
    if (((REPEAT_MASK) >> 11) & 1) { for (int q_ = 0; q_ < 8; ++q_) xcd_barrier(bar); }
    REP(1) { PH_IDS(); p1_rows(p, gw_, NGW, lane_); p1_extra(p, lds, vcu, G, tid_, wave_, lane_); }
    xcd_barrier(bar);
    REP(2) { const int n1_ = (rep_ == 1) ? 3072 : N1; pg8::Gemm g{(const u16*)(p.ws + WS_H), (const u16*)(p.ws + WS_H), (const u16*)(p.ws + WS_WIN), nullptr, M, n1_, DM, DM, DM / 64}; pg8::StaticOrder S; S.init(M, n1_, G, bx);
      EpiInProj E{p.ws, p.g_q, p.g_k};
      pg8::gemm_phase<EpiInProj, true>(lds, g, S, E);
      if (G == 256 && bx >= 64) { PH_IDS(); (void)gw_; late_weights(p, lds, (bx - 64) * NWAVES + wave_, 192 * NWAVES, wave_, lane_); }
      else if (G != 256) { PH_IDS(); late_weights(p, lds, gw_, NGW, wave_, lane_); }
      __syncthreads(); }
    xcd_barrier(bar);
    REP(3) if (G == 256) {
        const int b = vcu >> 7, i = vcu & 127;
        { PH_IDS(); (void)gw_; idx_unit<0>(p, lds, b, 255 - i, tid_, wave_, lane_); }
        { PH_IDS(); (void)gw_; idx_unit<0>(p, lds, b, i, tid_, wave_, lane_); }
    }
#ifdef IDX_VAR
    if (G == 256) {
        const int b = vcu >> 7, i = vcu & 127;
        { PH_IDS(); (void)gw_; idx_unit<IDX_VAR>(p, lds, b, 255 - i, tid_, wave_, lane_); }
        { PH_IDS(); (void)gw_; idx_unit<IDX_VAR>(p, lds, b, i, tid_, wave_, lane_); }
    }
#endif
    REP(9) if (G == 256) {
        { PH_IDS(); (void)gw_; conv_unit(p, lds, 2 * vcu, tid_, wave_, lane_); }
        { PH_IDS(); (void)gw_; conv_unit(p, lds, 2 * vcu + 1, tid_, wave_, lane_); }
    }
    xcd_barrier(bar);
    REP(4) if (G == 256) {
        const int bh = vcu >> 4, j = vcu & 15;
        { PH_IDS(); (void)gw_; attn_unit(p, lds, bh >> 3, bh & 7, 31 - j, tid_, wave_, lane_); }
        { PH_IDS(); (void)gw_; attn_unit(p, lds, bh >> 3, bh & 7, j, tid_, wave_, lane_); }
    }
    xcd_barrier(bar);
#ifdef DEBUG_CHECK
    { PH_IDS(); dbg_attn_check(p, gw_, NGW, lane_); dbg_idx_check(p, gw_, NGW, lane_); }
    xcd_barrier(bar);
#endif
    REP(6) { pg8::Gemm g{(const u16*)(p.ws + WS_ATT), (const u16*)(p.ws + WS_CONV), (const u16*)(p.ws + WS_WOUT), nullptr, M, DM, DM, AW, AW / 64}; pg8::StaticOrder S; S.init(M, DM, G, bx);
      EpiOut E{p.x, (u16*)(p.ws + WS_X1B), (float*)(p.ws + (rep_ == 0 ? WS_SS2 : WS_H)), (const float*)(p.ws + WS_MOD), (const float*)(p.ws + WS_SSP)};
      pg8::gemm_phase<EpiOut, false>(lds, g, S, E); }
    xcd_barrier(bar);
    REP(8) { pg8::Gemm g{(const u16*)(p.ws + WS_X1B), (const u16*)(p.ws + WS_X1B), (const u16*)(p.ws + WS_W1), (const u16*)(p.ws + WS_W1) + (size_t)DFF * DM, M, DFF, DM, DM, DM / 64}; pg8::StaticOrder S; S.init(M, DFF, G, bx);
      EpiFF1 E{(u16*)(p.ws + WS_F1), (const float*)(p.ws + WS_SS2), (const float*)(p.ws + WS_CB)};
      pg8::gemm_phase<EpiFF1, false>(lds, g, S, E); }
    xcd_barrier(bar);
    REP(10) { pg8::Gemm g{(const u16*)(p.ws + WS_F1), (const u16*)(p.ws + WS_F1), (const u16*)(p.ws + WS_W2), nullptr, M, DM, DFF, DFF, DFF / 64}; pg8::StaticOrder S; S.init(M, DM, G, bx);
      EpiFinal E{(const u16*)(p.ws + WS_X1B), p.out, (const float*)(p.ws + WS_MOD)};
      pg8::gemm_phase<EpiFinal, false>(lds, g, S, E); }
#ifdef DEBUG_CHECK
    xcd_barrier(bar);
    { PH_IDS(); dbg_encode(p, gw_, NGW, lane_); }
#endif
}

extern "C" void kernel_launch(void* const* d_in, const int* in_sizes, int n_in, void* d_out, int out_size, void* d_ws, size_t ws_size, hipStream_t stream) {
    static int grid = 0;
    if (grid == 0) {
        int dev = 0, cus = 0, per_cu = 0;
        if (n_in != 18 || out_size != M * DM || ws_size < WS_END) { fprintf(stderr, "kernel_launch: unexpected shapes (n_in %d out %d ws %zu)\n", n_in, out_size, ws_size); grid = -1; return; }
        if (hipGetDevice(&dev) != hipSuccess || hipDeviceGetAttribute(&cus, hipDeviceAttributeMultiprocessorCount, dev) != hipSuccess) { grid = -1; return; }
        if (hipFuncSetAttribute((const void*)fwd_megakernel, hipFuncAttributeMaxDynamicSharedMemorySize, LDS_BYTES) != hipSuccess) { fprintf(stderr, "kernel_launch: hipFuncSetAttribute failed\n"); grid = -1; return; }
        if (hipOccupancyMaxActiveBlocksPerMultiprocessor(&per_cu, (const void*)fwd_megakernel, NTHR, LDS_BYTES) != hipSuccess || per_cu < 1) { fprintf(stderr, "kernel_launch: occupancy query says %d\n", per_cu); per_cu = 1; }
        (void)hipGetLastError();
        grid = cus;
        if (grid != 256) fprintf(stderr, "kernel_launch: %d CUs, expected 256\n", grid);
    }
    if (grid < 0) return;
    if (hipMemsetAsync((char*)d_ws + WS_CTL, 0, CTL_ZERO_BYTES, stream) != hipSuccess) return;
    Params p{};
    const float** pp = (const float**)&p;
    for (int i = 0; i < 18; ++i) pp[i] = (const float*)d_in[i];
    p.out = (float*)d_out; p.ws = (unsigned char*)d_ws;
    void* args[] = {&p};
    hipError_t e = hipLaunchCooperativeKernel((void*)fwd_megakernel, dim3(grid), dim3(NTHR), args, LDS_BYTES, stream);
    if (e != hipSuccess) fprintf(stderr, "cooperative launch failed: %s (grid %d)\n", hipGetErrorString(e), grid);
}
```

```cpp
#ifndef REPEAT_MASK
#define REPEAT_MASK 0
#endif
#define REP(k) for (int rep_ = 0; rep_ < (((REPEAT_MASK) >> (k)) & 1) + 1; ++rep_)
#include <hip/hip_runtime.h>
#include <hip/hip_cooperative_groups.h>
#include <cstdio>
#include <cstdint>
#include <cmath>
#include <type_traits>

#define LAS __attribute__((address_space(3)))
#define GAS __attribute__((address_space(1)))
typedef unsigned short u16;
typedef short s16x8 __attribute__((ext_vector_type(8)));
typedef short s16x4 __attribute__((ext_vector_type(4)));
typedef _Float16 h16x8 __attribute__((ext_vector_type(8)));
typedef __bf16 b16x8 __attribute__((ext_vector_type(8)));
typedef float f32x4 __attribute__((ext_vector_type(4)));
typedef float f32x16 __attribute__((ext_vector_type(16)));
typedef unsigned u32x4 __attribute__((ext_vector_type(4)));
typedef unsigned u32x2 __attribute__((ext_vector_type(2)));

constexpr int SEQ = 8192, NB = 2, M = NB * SEQ, DM = 1024, DFF = 4096;
constexpr int AW = 512, NH = 8, HD = 64, CW = 512, CK = 31;
constexpr int IN_COLS = 3144, N1 = 3328;
constexpr int C_Q = 0, C_K = 512, C_V = 1024, C_IQ = 1536, C_IK = 2048, C_IW = 2112, C_CA = 2120, C_CG = 2632;
constexpr float EPS = 1e-6f;
constexpr float QSCALE = 0.125f * 1.4426950408889634f;
constexpr float IWSCALE = 0.35355339059327373f * 0.125f;
constexpr float SM_OFF = 8.0f;

constexpr size_t MiB = 1u << 20;
constexpr size_t WS_CTL = 0, CTL_ZERO_BYTES = 64 * 1024;
constexpr size_t WS_MOD = 1 * MiB;
constexpr size_t WS_COS = 1 * MiB + 64 * 1024;
constexpr size_t WS_SIN = WS_COS + 256 * 1024;
constexpr size_t WS_WIN = 2 * MiB;
constexpr size_t WS_WOUT = 9 * MiB;
constexpr size_t WS_W1 = 240 * MiB;
constexpr size_t WS_W2 = 19 * MiB;
constexpr size_t WS_SSP = 27 * MiB;
constexpr size_t WS_SS2 = 27 * MiB + 512 * 1024;
constexpr size_t WS_IW = 28 * MiB;
constexpr size_t WS_CB = 28 * MiB + 512 * 1024;
constexpr size_t WS_IK = 29 * MiB;
constexpr size_t WS_H = 32 * MiB;
constexpr size_t WS_Q = 64 * MiB, WS_K = 80 * MiB, WS_V = 96 * MiB;
constexpr size_t WS_IQ = 112 * MiB;
constexpr size_t WS_GLU = 128 * MiB;
constexpr size_t WS_MASK = 144 * MiB;
constexpr size_t WS_ATT = 160 * MiB;
constexpr size_t WS_CONV = 176 * MiB;
constexpr size_t WS_X1B = 208 * MiB;
constexpr size_t WS_F1 = 32 * MiB;
constexpr size_t WS_END = 256 * MiB;
constexpr int CW_BAR = 4096;

constexpr int NWAVES = 8, NTHR = 512;
constexpr int LDS_BYTES = 147456;
constexpr int RING_BYTES = 131072;
constexpr int MISC_OFF = LDS_BYTES - 256;

__device__ __forceinline__ unsigned f2bf(float f) { unsigned u = __builtin_bit_cast(unsigned, f); return (u + 0x7fffu + ((u >> 16) & 1u)) >> 16; }
typedef float f32x2_t __attribute__((ext_vector_type(2))); typedef __bf16 bf16x2_t __attribute__((ext_vector_type(2)));
__device__ __forceinline__ unsigned pk2bf(float lo, float hi) { f32x2_t v = {lo, hi}; bf16x2_t b = __builtin_convertvector(v, bf16x2_t); return __builtin_bit_cast(unsigned, b); }
__device__ __forceinline__ unsigned pk2h(float lo, float hi) { _Float16 a = (_Float16)lo, b = (_Float16)hi; return (unsigned)__builtin_bit_cast(u16, a) | ((unsigned)__builtin_bit_cast(u16, b) << 16); }
__device__ __forceinline__ float bf2f(unsigned short v) { return __builtin_bit_cast(float, (unsigned)v << 16); }
__device__ __forceinline__ float wave_sum(float v) {
#pragma unroll
    for (int o = 1; o < 64; o <<= 1) v += __shfl_xor(v, o);
    return v;
}
__device__ __forceinline__ unsigned lds_add_u32(LAS unsigned* p, unsigned v) { return __hip_atomic_fetch_add(p, v, __ATOMIC_RELAXED, __HIP_MEMORY_SCOPE_WORKGROUP); }
__device__ __forceinline__ unsigned lds_or_u32(LAS unsigned* p, unsigned v) { return __hip_atomic_fetch_or(p, v, __ATOMIC_RELAXED, __HIP_MEMORY_SCOPE_WORKGROUP); }
__device__ __forceinline__ int opaque_tid() { int t = threadIdx.x; asm volatile("" : "+v"(t)); return t; }
#define LDS_WAIT() asm volatile("s_waitcnt lgkmcnt(0)" ::: "memory")
#define VM_WAIT() asm volatile("s_waitcnt vmcnt(0)" ::: "memory")

namespace pg8 {
constexpr int BM = 256, BK = 64, HALF = 128, HTB = HALF * BK * 2, STAGE_BYTES = 8 * HTB, NXCD = 8, WGM = 8;
__host__ __device__ __forceinline__ int lds_byte(int r, int c) { const int st = (r >> 4) * 2 + (c >> 5), rr = r & 15, cc = c & 31, ob = rr * 64 + cc * 2; return st * 1024 + (ob ^ (((ob >> 9) & 1) << 5)); }
__host__ __device__ __forceinline__ void stage_rc(int b, int& R, int& C) { const int st = b / 1024, sb = b % 1024, swz = sb ^ (((sb >> 9) & 1) << 5); R = (st >> 1) * 16 + swz / 64; C = (st & 1) * 32 + (swz % 64) / 2; }
__host__ __device__ __forceinline__ int perm32(int rho) { const int n = rho >> 4, i = rho & 15; return 8 * (i >> 2) + 4 * n + (i & 3); }
struct Unit { int pm, pn; };
struct Gemm { const u16* A; const u16* A2; const u16* Bt; const u16* Bt2; int M, N, K, lda, ksplit; };
struct StaticOrder {
    int nM, nN, nwg, G, c;
    __host__ __device__ void init(int M_, int N_, int G_, int c_) { nM = M_ / BM; nN = N_ / BM; nwg = nM * nN; G = G_; c = c_; }
    __host__ __device__ bool next(int i, Unit& u) const {
        const long L = (long)i * G + c; if (L >= nwg) return false;
        int wgid = (int)L; { const int q = nwg / NXCD, r = nwg % NXCD, xcd = wgid % NXCD, off = wgid / NXCD; wgid = (xcd < r ? xcd * (q + 1) : r * (q + 1) + (xcd - r) * q) + off; }
        const int nig = WGM * nN, gid = wgid / nig, fm = gid * WGM, gsz = (nM - fm) < WGM ? (nM - fm) : WGM;
        u.pm = fm + ((wgid % nig) % gsz); u.pn = (wgid % nig) / gsz; return true;
    }
};
template <bool F16> __device__ __forceinline__ f32x4 mma16(s16x8 a, s16x8 b, f32x4 c) {
    if constexpr (F16) return __builtin_amdgcn_mfma_f32_16x16x32_f16(__builtin_bit_cast(h16x8, a), __builtin_bit_cast(h16x8, b), c, 0, 0, 0);
    else return __builtin_amdgcn_mfma_f32_16x16x32_bf16(__builtin_bit_cast(b16x8, a), __builtin_bit_cast(b16x8, b), c, 0, 0, 0);
}
template <class Epi, bool F16>
__device__ __forceinline__ void gemm_phase(LAS unsigned char* lds, const Gemm g, const StaticOrder& S, const Epi& E) {
    const int tid = opaque_tid(), wid = __builtin_amdgcn_readfirstlane(tid >> 6), lane = tid & 63, wr = wid >> 2, wc = wid & 3, fr = lane & 15, fq = lane >> 4;
    const int K = g.K, nt = K / BK;
    unsigned voffA[2], voffB[2];
#pragma unroll
    for (int i = 0; i < 2; ++i) { int R, C; stage_rc(tid * 16 + i * 8192, R, C); const int Rb = Epi::PERM ? ((R & ~31) + perm32(R & 31)) : R;
        voffA[i] = (unsigned)(R * g.lda + C) * 2u; voffB[i] = (unsigned)(Rb * K + C) * 2u; }
    const size_t kstep = (size_t)(BK * 2);
    const size_t hstep = (size_t)HALF * K * 2;
    const size_t tstep = 2 * hstep;
    const size_t hstepA = (size_t)HALF * g.lda * 2, tstepA = 2 * hstepA;
    const int ksplit = g.ksplit;
    const unsigned ldsw = (unsigned)wid * 1024u;
    const int aoff = lds_byte(wr * 64 + fr, fq * 8), boff = lds_byte(wc * 32 + fr, fq * 8);
#define PG8_SA(b, h) (((b) * 2 + (h)) * HTB)
#define PG8_SB(b, h) ((4 + (b) * 2 + (h)) * HTB)
#define PG8_STAGE(bufoff, gbase, voff) do { _Pragma("unroll") for (int _i = 0; _i < 2; ++_i) \
        __builtin_amdgcn_global_load_lds((const unsigned*)((const char*)(gbase) + (voff)[_i]), (LAS unsigned*)(lds + (bufoff) + ldsw + _i * 8192), 16, 0, 0); } while (0)
#define PG8_LDA(dst, b, h) do { _Pragma("unroll") for (int m = 0; m < 4; ++m) _Pragma("unroll") for (int k = 0; k < 2; ++k) dst[m][k] = *(const LAS s16x8*)(lds + PG8_SA(b, h) + aoff + m * 2048 + k * 1024); } while (0)
#define PG8_LDB(dst, b, h) do { _Pragma("unroll") for (int n = 0; n < 2; ++n) _Pragma("unroll") for (int k = 0; k < 2; ++k) dst[n][k] = *(const LAS s16x8*)(lds + PG8_SB(b, h) + boff + n * 2048 + k * 1024); } while (0)
#define PG8_MMA(ai, bj, At, Bt) do { __builtin_amdgcn_s_setprio(1); _Pragma("unroll") for (int m = 0; m < 4; ++m) _Pragma("unroll") for (int n = 0; n < 2; ++n) _Pragma("unroll") for (int k = 0; k < 2; ++k) \
        acc[ai][bj][m][n] = mma16<F16>(Bt[n][k], At[m][k], acc[ai][bj][m][n]); __builtin_amdgcn_s_setprio(0); } while (0)
#define PG8_WAIT_V(n) asm volatile("s_waitcnt vmcnt(" #n ")" ::: "memory")
#define PG8_WAIT_L(n) asm volatile("s_waitcnt lgkmcnt(" #n ")" ::: "memory")
#define PG8_BAR __builtin_amdgcn_s_barrier()
#define PG8_SCHED __builtin_amdgcn_sched_barrier(0)
    Unit cur, nxt; int ui = 0;
    if (!S.next(0, cur)) return;
    f32x4 acc[2][2][4][2];
#pragma unroll
    for (int a = 0; a < 2; ++a)
#pragma unroll
        for (int b = 0; b < 2; ++b)
#pragma unroll
            for (int m = 0; m < 4; ++m)
#pragma unroll
                for (int n = 0; n < 2; ++n) acc[a][b][m][n] = (f32x4){0.f, 0.f, 0.f, 0.f};
    s16x8 At[4][2], B0[2][2], B1[2][2];
    float midrs[2][4];
    if constexpr (Epi::HAS_MID) E.pre(midrs, cur, wr, fr);
#define PG8_BSEL(u_) ((g.Bt2 && (u_).pm * BM >= g.M / 2) ? (const char*)g.Bt2 : (const char*)g.Bt)
#define PG8_AT(b1, b2, t_) ((t_) < ksplit ? (b1) + (size_t)(t_) * kstep : (b2) + (size_t)((t_) - ksplit) * kstep)
    const char* cA = (const char*)g.A + (size_t)cur.pm * tstepA; const char* cA2 = (const char*)g.A2 + (size_t)cur.pm * tstepA; const char* cB = PG8_BSEL(cur) + (size_t)cur.pn * tstep;
    PG8_STAGE(PG8_SB(0, 0), cB, voffB); PG8_STAGE(PG8_SB(0, 1), cB + hstep, voffB); PG8_STAGE(PG8_SA(0, 0), cA, voffA); PG8_STAGE(PG8_SA(0, 1), cA + hstepA, voffA);
    if (wr == 1) PG8_BAR;
    PG8_WAIT_V(2); PG8_BAR;
    PG8_STAGE(PG8_SB(1, 0), cB + kstep, voffB); PG8_STAGE(PG8_SA(1, 0), cA + kstep, voffA); PG8_STAGE(PG8_SB(1, 1), cB + hstep + kstep, voffB);
    PG8_WAIT_V(6); PG8_BAR;
    for (;;) {
        const bool has_next = S.next(ui + 1, nxt);
        const char* nA = has_next ? (const char*)g.A + (size_t)nxt.pm * tstepA : cA; const char* nA2 = has_next ? (const char*)g.A2 + (size_t)nxt.pm * tstepA : cA2; const char* nB = has_next ? PG8_BSEL(nxt) + (size_t)nxt.pn * tstep : cB;
        for (int t = 0; t < nt; t += 2) {
            const bool last = (t == nt - 2);
            const char* a1 = PG8_AT(cA, cA2, t + 1);
            const char* a2 = last ? nA : PG8_AT(cA, cA2, t + 2); const char* b2 = last ? nB : cB + (size_t)(t + 2) * kstep;
            const char* a3 = last ? nA + kstep : PG8_AT(cA, cA2, t + 3); const char* b3 = b2 + kstep;
            PG8_LDB(B0, 0, 0); PG8_LDB(B1, 0, 1); PG8_SCHED; PG8_LDA(At, 0, 0); PG8_STAGE(PG8_SA(1, 1), a1 + hstepA, voffA);
            PG8_WAIT_V(8); PG8_WAIT_L(0); PG8_BAR; PG8_MMA(0, 0, At, B0); PG8_MMA(0, 1, At, B1); PG8_BAR; PG8_SCHED;
            PG8_LDA(At, 0, 1); PG8_STAGE(PG8_SB(0, 0), b2, voffB); PG8_STAGE(PG8_SB(0, 1), b2 + hstep, voffB); PG8_STAGE(PG8_SA(0, 0), a2, voffA);
            PG8_WAIT_V(8); PG8_WAIT_L(0); PG8_BAR; PG8_MMA(1, 0, At, B0); PG8_MMA(1, 1, At, B1); PG8_BAR; PG8_SCHED;
            PG8_LDB(B0, 1, 0); PG8_LDB(B1, 1, 1); PG8_SCHED; PG8_LDA(At, 1, 0); PG8_STAGE(PG8_SA(0, 1), a2 + hstepA, voffA);
            PG8_WAIT_V(8); PG8_WAIT_L(0); PG8_BAR; PG8_MMA(0, 0, At, B0); PG8_MMA(0, 1, At, B1); PG8_BAR; PG8_SCHED;
            PG8_LDA(At, 1, 1); PG8_STAGE(PG8_SB(1, 0), b3, voffB); PG8_STAGE(PG8_SB(1, 1), b3 + hstep, voffB); PG8_STAGE(PG8_SA(1, 0), a3, voffA);
            PG8_WAIT_V(8); PG8_WAIT_L(0); PG8_BAR; PG8_MMA(1, 0, At, B0); PG8_MMA(1, 1, At, B1); PG8_BAR; PG8_SCHED;
            if constexpr (Epi::HAS_MID) { if (t + 2 == ksplit) E.mid(acc, midrs); }
        }
        if (wr == 0) PG8_BAR;
        E(acc, cur, wr, wc, fr, fq);
        if (!has_next) break;
#pragma unroll
        for (int a = 0; a < 2; ++a)
#pragma unroll
            for (int b = 0; b < 2; ++b)
#pragma unroll
                for (int m = 0; m < 4; ++m)
#pragma unroll
                    for (int n = 0; n < 2; ++n) acc[a][b][m][n] = (f32x4){0.f, 0.f, 0.f, 0.f};
        cur = nxt; cA = nA; cA2 = nA2; cB = nB; ++ui;
        if constexpr (Epi::HAS_MID) E.pre(midrs, cur, wr, fr);
        if (wr == 1) PG8_BAR;
    }
    PG8_WAIT_V(0);
    PG8_BAR;
#undef PG8_BSEL
#undef PG8_AT
#undef PG8_SA
#undef PG8_SB
#undef PG8_STAGE
#undef PG8_LDA
#undef PG8_LDB
#undef PG8_MMA
#undef PG8_WAIT_V
#undef PG8_WAIT_L
#undef PG8_BAR
#undef PG8_SCHED
}
}

#define XB_TMO      128
#define XB_XCNT(j)  (256  + 64 * (j))
#define XB_XSUB(j)  (1280 + 64 * (j))
#define XB_XGEN(j)  (2304 + 64 * (j))
#define XB_TOP      3328
#define XB_TOPGEN   3392
#define XCD_BAR_WORDS 3456
#define XB_SPIN_CAP (1u << 18)
__device__ __forceinline__ unsigned xb_ld(unsigned* p)              { return __hip_atomic_load(p, __ATOMIC_RELAXED, __HIP_MEMORY_SCOPE_AGENT); }
__device__ __forceinline__ unsigned xb_add(unsigned* p, unsigned v) { return __hip_atomic_fetch_add(p, v, __ATOMIC_RELAXED, __HIP_MEMORY_SCOPE_AGENT); }
__device__ __forceinline__ unsigned xb_xcc_id() { return (unsigned)__builtin_amdgcn_s_getreg((3 << 11) | 20) & 0xFu; }
#define XB_SPIN(cond, bar) do { unsigned _sp = 0; while (cond) { __builtin_amdgcn_s_sleep(1); \
    if ((++_sp & 255u) == 0u) { if (xb_ld(&(bar)[XB_TMO])) break; if (_sp > XB_SPIN_CAP) { atomicAdd(&(bar)[XB_TMO], 1u); break; } } } } while (0)
struct XcdBarrier { unsigned* bar; unsigned x; volatile LAS unsigned* st; };
__device__ __forceinline__ XcdBarrier xcd_barrier_post(unsigned* bar, volatile LAS unsigned* st) {
    XcdBarrier b; b.bar = bar; b.x = xb_xcc_id(); b.st = st;
    if (threadIdx.x == 0) (void)xb_add(&bar[XB_XCNT(b.x)], 1u);
    return b;
}
__device__ __forceinline__ void xcd_barrier_complete(unsigned* bar, unsigned x, unsigned& nloc, unsigned& nx) {
    const unsigned G = gridDim.x * gridDim.y * gridDim.z;
    unsigned sum, cnt, mine, sp = 0u;
    for (;;) {
        sum = 0u; cnt = 0u; mine = 0u;
#pragma unroll
        for (unsigned j = 0; j < 16; ++j) { const unsigned c = xb_ld(&bar[XB_XCNT(j)]); sum += c; cnt += (c > 0u) ? 1u : 0u; mine = (j == x) ? c : mine; }
        if (sum == G) break;
        __builtin_amdgcn_s_sleep(1);
        if ((++sp & 255u) == 0u) { if (xb_ld(&bar[XB_TMO])) break; if (sp > XB_SPIN_CAP) { atomicAdd(&bar[XB_TMO], 1u); break; } }
    }
    nloc = mine > 0u ? mine : 1u; nx = cnt > 0u ? cnt : 1u;
}
__device__ __forceinline__ void xcd_barrier(const XcdBarrier& b) {
    asm volatile("s_waitcnt vmcnt(0)" ::: "memory");
    __syncthreads();
    if (threadIdx.x == 0) {
        unsigned* bar = b.bar;
        __builtin_amdgcn_s_waitcnt(0);
        unsigned nloc = b.st[0], nx = b.st[1];
        if (nloc == 0u) { xcd_barrier_complete(bar, b.x, nloc, nx); b.st[0] = nloc; b.st[1] = nx; }
        const unsigned old = xb_add(&bar[XB_XSUB(b.x)], 1u);
        const unsigned gen = old / nloc;
        if (old + 1u == (gen + 1u) * nloc) {
            __builtin_amdgcn_fence(__ATOMIC_RELEASE, "agent");
            asm volatile("s_waitcnt vmcnt(0)" ::: "memory");
            const unsigned og = xb_add(&bar[XB_TOP], 1u);
            const unsigned tg = og / nx;
            if (og + 1u == (tg + 1u) * nx) xb_add(&bar[XB_TOPGEN], 1u);
            else XB_SPIN(xb_ld(&bar[XB_TOPGEN]) == tg, bar);
            __builtin_amdgcn_fence(__ATOMIC_ACQUIRE, "agent");
            xb_add(&bar[XB_XGEN(b.x)], 1u);
            asm volatile("s_waitcnt vmcnt(0)" ::: "memory");
        } else {
            XB_SPIN(xb_ld(&bar[XB_XGEN(b.x)]) == gen, bar);
            __builtin_amdgcn_fence(__ATOMIC_ACQUIRE, "agent");
            asm volatile("s_waitcnt vmcnt(0)" ::: "memory");
        }
    }
    __syncthreads();
}

struct Params {
    const float *x, *c, *w_ada, *b_ada, *g_norm1, *w_in, *g_q, *g_k, *w_dw, *b_dw, *g_conv_ln, *b_conv_ln, *g_out_attn, *g_out_conv, *w_out, *g_norm2, *w_ff1, *w_ff2;
    float* out; unsigned char* ws;
};

template <bool F16, class SrcCol>
__device__ __forceinline__ void transpose_item(const float* W, int K, int Nsrc, u16* WT, const float* rs, LAS float* scr, int item, int nblk, int lane, SrcCol srccol, const float* rs2 = nullptr) {
    const int kb = item / nblk, nb = item % nblk, k0 = 64 * kb, n0 = 32 * nb;
    const int c4 = (lane & 7) * 4, r8 = lane >> 3; const int sc = srccol(n0 + c4); const bool run4 = sc >= 0 && srccol(n0 + c4 + 3) == sc + 3;
    f32x4 v[8];
    if (run4) {
#pragma unroll
        for (int i = 0; i < 8; ++i) v[i] = *(const f32x4*)(W + (size_t)(k0 + r8 + 8 * i) * Nsrc + sc);
    } else {
#pragma unroll
        for (int i = 0; i < 8; ++i)
#pragma unroll
            for (int e = 0; e < 4; ++e) { const int s1 = srccol(n0 + c4 + e); v[i][e] = s1 >= 0 ? W[(size_t)(k0 + r8 + 8 * i) * Nsrc + s1] : 0.f; }
    }
#pragma unroll
    for (int i = 0; i < 8; ++i) { const int kk = r8 + 8 * i; float sc1 = 1.f; if (rs) sc1 = rs[k0 + kk]; if (rs2) sc1 *= 1.f + rs2[k0 + kk];
#pragma unroll
        for (int e = 0; e < 4; ++e) scr[kk * 33 + c4 + e] = v[i][e] * sc1; }
    LDS_WAIT(); asm volatile("" ::: "memory");
    const int c = lane & 7;
#pragma unroll
    for (int j = 0; j < 4; ++j) { const int n = (lane >> 3) + 8 * j; const LAS float* s = scr + (8 * c) * 33 + n;
        u32x4 o;
        if (F16) { o.x = pk2h(s[0 * 33], s[1 * 33]); o.y = pk2h(s[2 * 33], s[3 * 33]); o.z = pk2h(s[4 * 33], s[5 * 33]); o.w = pk2h(s[6 * 33], s[7 * 33]); }
        else { o.x = pk2bf(s[0 * 33], s[1 * 33]); o.y = pk2bf(s[2 * 33], s[3 * 33]); o.z = pk2bf(s[4 * 33], s[5 * 33]); o.w = pk2bf(s[6 * 33], s[7 * 33]); }
        *(u32x4*)(WT + (size_t)(n0 + n) * K + k0 + 8 * c) = o; }
    LDS_WAIT(); asm volatile("" ::: "memory");
}
__device__ __forceinline__ int win_srccol(int p) {
    const int pn = p >> 8, r = p & 255, bj = r >> 7, wc = (r >> 5) & 3, i = r & 31;
    if (pn < 6) { const int base = (pn >> 1) * 512; const int head = 4 * (pn & 1) + wc; return base + head * 64 + 32 * bj + i; }
    if (pn < 10) { const int ch = 128 * (pn - 6) + 32 * wc + i; return (bj == 0 ? C_CA : C_CG) + ch; }
    if (pn < 12) { const int head = 4 * (pn - 10) + wc; return C_IQ + head * 64 + 32 * bj + i; }
    if (wc == 0) return C_IK + 32 * bj + i;
    if (wc == 1 && bj == 0 && i < 8) return C_IW + i;
    return -1;
}
__device__ __forceinline__ void p0_phase(const Params& p, LAS unsigned char* lds, int vcu, int G, int tid, int wave, int lane) {
    unsigned char* ws = p.ws;
    { float* cosT = (float*)(ws + WS_COS); float* sinT = (float*)(ws + WS_SIN);
      for (int e = vcu * NTHR + tid; e < SEQ * 8; e += G * NTHR) { const int pos = e >> 3, i = e & 7;
          const float inv = (float)pow(500000.0, -(double)i / 8.0); const float ang = (float)pos * inv; const double a = (double)ang;
          cosT[e] = (float)cos(a); sinT[e] = (float)sin(a); } }
    if (vcu < 192) {
        LAS float* sc = (LAS float*)lds;
        LAS float* red = (LAS float*)(lds + 8192);
        for (int e = tid; e < 2048; e += NTHR) { const float v = p.c[e]; sc[e] = v / (1.f + __expf(-v)); }
        __syncthreads();
        const int kl = tid >> 3, cq = tid & 7, c0 = vcu * 32 + cq * 4;
        f32x4 a0 = {0.f, 0.f, 0.f, 0.f}, a1 = {0.f, 0.f, 0.f, 0.f};
        f32x4 wv[16];
#pragma unroll
        for (int i = 0; i < 16; ++i) wv[i] = __builtin_nontemporal_load((const f32x4*)(p.w_ada + (size_t)(kl + 64 * i) * 6144 + c0));
#pragma unroll
        for (int i = 0; i < 16; ++i) { const int k = kl + 64 * i; a0 += wv[i] * sc[k]; a1 += wv[i] * sc[1024 + k]; }
        *(LAS f32x4*)(red + (kl * 8 + cq) * 8) = a0; *(LAS f32x4*)(red + (kl * 8 + cq) * 8 + 4) = a1;
        __syncthreads();
        if (tid < 64) { const int cq2 = tid >> 3, j = tid & 7; float s = 0.f;
            for (int k2 = 0; k2 < 64; ++k2) s += red[(k2 * 8 + cq2) * 8 + j];
            const int b = j >> 2, col = vcu * 32 + cq2 * 4 + (j & 3);
            ((float*)(ws + WS_MOD))[b * 6144 + col] = s + p.b_ada[col]; }
        __syncthreads();
    }
    LAS float* scr = (LAS float*)(lds + 32768 + wave * 8704);
    const int gw = vcu * NWAVES + wave, NGW = G * NWAVES;
    constexpr int I_IN = (DM / 64) * (N1 / 32), I_O = (DM / 64) * (DM / 32), I_1 = (DM / 64) * (DFF / 32), I_2 = (DFF / 64) * (DM / 32);
    { float* ss2 = (float*)(ws + WS_SS2); for (int e = vcu * NTHR + tid; e < M; e += G * NTHR) ss2[e] = 0.f; }
    for (int it = gw; it < I_IN; it += NGW)
        transpose_item<true>(p.w_in, DM, IN_COLS, (u16*)(ws + WS_WIN), nullptr, scr, it, N1 / 32, lane, [](int n) { return win_srccol(n); });
}
__device__ __forceinline__ void late_weights(const Params& p, LAS unsigned char* lds, int widx, int nw, int wave, int lane) {
    unsigned char* ws = p.ws; const float* mod = (const float*)(ws + WS_MOD);
    LAS float* scr = (LAS float*)(lds + 32768 + wave * 8704);
    constexpr int I_O = (DM / 64) * (DM / 32), I_1 = (DM / 64) * (DFF / 32), I_2 = (DFF / 64) * (DM / 32);
    for (int it = widx; it < I_O + I_2 + 2 * I_1; it += nw) {
        int r = it;
        if (r < I_O) { const int kb = r / (DM / 32); const float* rs = (kb < 8) ? p.g_out_attn : (p.g_out_conv - 512);
            transpose_item<false>(p.w_out, DM, DM, (u16*)(ws + WS_WOUT), rs, scr, r, DM / 32, lane, [](int n) { return n; }); continue; } r -= I_O;
        if (r < I_2) { transpose_item<false>(p.w_ff2, DFF, DM, (u16*)(ws + WS_W2), nullptr, scr, r, DM / 32, lane, [](int n) { return n; }); continue; } r -= I_2;
        const int b = r / I_1; r -= b * I_1;
        transpose_item<false>(p.w_ff1, DM, DFF, (u16*)(ws + WS_W1) + (size_t)b * DFF * DM, p.g_norm2, scr, r, DFF / 32, lane, [](int n) { return n; }, mod + b * 6144 + 4096);
    }
}

__device__ __forceinline__ void p1_rows(const Params& p, int gw, int NGW, int lane) {
    const float* mod = (const float*)(p.ws + WS_MOD); u16* H = (u16*)(p.ws + WS_H);
    for (int m0 = gw * 4; m0 < M; m0 += NGW * 4) {
        f32x4 v[4][4];
#pragma unroll
        for (int r = 0; r < 4; ++r) { const f32x4* xr = (const f32x4*)(p.x + (size_t)(m0 + r) * DM) + lane;
#pragma unroll
            for (int j = 0; j < 4; ++j) v[r][j] = __builtin_nontemporal_load(xr + 64 * j); }
        const int b = m0 / SEQ; const float* sh = mod + b * 6144; const float* scl = mod + b * 6144 + 1024;
        f32x4 gm[4], hm[4];
#pragma unroll
        for (int j = 0; j < 4; ++j) { const int c = 4 * lane + 256 * j; const f32x4 g = *(const f32x4*)(p.g_norm1 + c), s1 = *(const f32x4*)(scl + c); gm[j] = g * (s1 + 1.f); hm[j] = *(const f32x4*)(sh + c); }
#pragma unroll
        for (int r = 0; r < 4; ++r) { float s = 0.f;
#pragma unroll
            for (int j = 0; j < 4; ++j) s += (v[r][j].x * v[r][j].x + v[r][j].y * v[r][j].y) + (v[r][j].z * v[r][j].z + v[r][j].w * v[r][j].w);
            const float rstd = 1.f / sqrtf(wave_sum(s) * (1.f / DM) + EPS);
            unsigned long long* o8 = (unsigned long long*)(H + (size_t)(m0 + r) * DM) + lane;
#pragma unroll
            for (int j = 0; j < 4; ++j) { const f32x4 y = v[r][j] * rstd * gm[j] + hm[j];
                o8[64 * j] = (unsigned long long)pk2h(y.x, y.y) | ((unsigned long long)pk2h(y.z, y.w) << 32); } }
    }
}

__device__ __forceinline__ void p1_extra(const Params& p, LAS unsigned char* lds, int vcu, int G, int tid, int wave, int lane) {
    unsigned char* ws = p.ws; const float* mod = (const float*)(ws + WS_MOD);
    if (vcu < 128) {
        LAS float* red = (LAS float*)lds;
        const int kl = tid >> 3, cq = tid & 7, c0 = vcu * 32 + cq * 4;
        f32x4 a0 = {0.f, 0.f, 0.f, 0.f}, a1 = {0.f, 0.f, 0.f, 0.f};
        f32x4 wv[16];
#pragma unroll
        for (int i = 0; i < 16; ++i) wv[i] = *(const f32x4*)(p.w_ff1 + (size_t)(kl + 64 * i) * DFF + c0);
#pragma unroll
        for (int i = 0; i < 16; ++i) { const int k = kl + 64 * i; a0 += wv[i] * mod[3072 + k]; a1 += wv[i] * mod[6144 + 3072 + k]; }
        *(LAS f32x4*)(red + (kl * 8 + cq) * 8) = a0; *(LAS f32x4*)(red + (kl * 8 + cq) * 8 + 4) = a1;
        __syncthreads();
        if (tid < 64) { const int cq2 = tid >> 3, j = tid & 7; float s = 0.f;
            for (int k2 = 0; k2 < 64; ++k2) s += red[(k2 * 8 + cq2) * 8 + j];
            const int b = j >> 2, col = vcu * 32 + cq2 * 4 + (j & 3);
            ((float*)(ws + WS_CB))[b * DFF + col] = s; }
        __syncthreads();
    }
}
struct EpiInProj {
    static constexpr bool PERM = true, HAS_MID = false;
    unsigned char* ws; const float* g_q; const float* g_k;
    __device__ __forceinline__ void operator()(const f32x4 (&acc)[2][2][4][2], const pg8::Unit& u, int wr, int wc, int fr, int fq) const {
        const int pn = u.pn; const int row0 = u.pm * 256 + wr * 64 + fr;
        const float* cosT = (const float*)(ws + WS_COS); const float* sinT = (const float*)(ws + WS_SIN);
        if (pn < 6 || pn == 10 || pn == 11 || (pn == 12 && wc == 0)) {
            const int kind = pn < 6 ? (pn >> 1) : (pn < 12 ? 3 : 4);
            const bool donorm = kind < 2, dorope = kind != 2, f16o = kind >= 3;
            const int head = kind < 3 ? 4 * (pn & 1) + wc : (kind == 3 ? 4 * (pn - 10) + wc : 0);
            u16* dst = (u16*)(ws + (kind == 0 ? WS_Q : kind == 1 ? WS_K : kind == 2 ? WS_V : kind == 3 ? WS_IQ : WS_IK));
            const int ld = kind == 4 ? 64 : 512;
            const float* gg = kind == 0 ? g_q : g_k;
            float gv[2][8];
#pragma unroll
            for (int bj = 0; bj < 2; ++bj)
#pragma unroll
                for (int e = 0; e < 8; ++e) gv[bj][e] = donorm ? gg[32 * bj + 8 * fq + e] * (kind == 0 ? QSCALE : 1.f) : 1.f;
#pragma unroll
            for (int ai = 0; ai < 2; ++ai)
#pragma unroll
                for (int m = 0; m < 4; ++m) {
                    const int row = row0 + ai * 128 + m * 16; const int pos = row & (SEQ - 1);
                    float v[2][8];
#pragma unroll
                    for (int bj = 0; bj < 2; ++bj)
#pragma unroll
                        for (int n = 0; n < 2; ++n)
#pragma unroll
                            for (int e = 0; e < 4; ++e) v[bj][4 * n + e] = acc[ai][bj][m][n][e];
                    float rstd = 1.f;
                    if (donorm) { float ss = 0.f;
#pragma unroll
                        for (int bj = 0; bj < 2; ++bj)
#pragma unroll
                            for (int e = 0; e < 8; ++e) ss += v[bj][e] * v[bj][e];
                        ss += __shfl_xor(ss, 16); ss += __shfl_xor(ss, 32);
                        rstd = 1.f / sqrtf(ss * (1.f / 64.f) + EPS); }
#pragma unroll
                    for (int bj = 0; bj < 2; ++bj)
#pragma unroll
                        for (int e = 0; e < 8; ++e) v[bj][e] = v[bj][e] * rstd * gv[bj][e];
                    if (dorope) {
                        const f32x4 c0 = *(const f32x4*)(cosT + pos * 8), c1 = *(const f32x4*)(cosT + pos * 8 + 4), s0 = *(const f32x4*)(sinT + pos * 8), s1 = *(const f32x4*)(sinT + pos * 8 + 4);
#pragma unroll
                        for (int e = 0; e < 8; ++e) { const float pv = __shfl_xor(v[0][e], 16); const float cc = e < 4 ? c0[e & 3] : c1[e & 3], sn = e < 4 ? s0[e & 3] : s1[e & 3];
                            const float r1 = v[0][e] * cc - pv * sn, r2 = v[0][e] * cc + pv * sn; v[0][e] = fq == 0 ? r1 : (fq == 1 ? r2 : v[0][e]); }
                    }
#pragma unroll
                    for (int bj = 0; bj < 2; ++bj) { u32x4 w;
                        if (f16o) { w.x = pk2h(v[bj][0], v[bj][1]); w.y = pk2h(v[bj][2], v[bj][3]); w.z = pk2h(v[bj][4], v[bj][5]); w.w = pk2h(v[bj][6], v[bj][7]); }
                        else { w.x = pk2bf(v[bj][0], v[bj][1]); w.y = pk2bf(v[bj][2], v[bj][3]); w.z = pk2bf(v[bj][4], v[bj][5]); w.w = pk2bf(v[bj][6], v[bj][7]); }
                        *(u32x4*)(dst + (size_t)row * ld + head * 64 + 32 * bj + 8 * fq) = w; }
                }
        } else if (pn < 10) {
            u16* dst = (u16*)(ws + WS_GLU);
#pragma unroll
            for (int ai = 0; ai < 2; ++ai)
#pragma unroll
                for (int m = 0; m < 4; ++m) { const int row = row0 + ai * 128 + m * 16; float o[8];
#pragma unroll
                    for (int n = 0; n < 2; ++n)
#pragma unroll
                        for (int e = 0; e < 4; ++e) { const float a = acc[ai][0][m][n][e], g = acc[ai][1][m][n][e]; o[4 * n + e] = a / (1.f + __expf(-g)); }
                    u32x4 w; w.x = pk2bf(o[0], o[1]); w.y = pk2bf(o[2], o[3]); w.z = pk2bf(o[4], o[5]); w.w = pk2bf(o[6], o[7]);
                    *(u32x4*)(dst + (size_t)row * CW + 128 * (pn - 6) + 32 * wc + 8 * fq) = w; }
        } else if (pn == 12 && wc == 1) {
            if (fq == 0) { float* dst = (float*)(ws + WS_IW);
#pragma unroll
                for (int ai = 0; ai < 2; ++ai)
#pragma unroll
                    for (int m = 0; m < 4; ++m) { const int row = row0 + ai * 128 + m * 16;
                        *(f32x4*)(dst + (size_t)row * 8) = acc[ai][0][m][0] * IWSCALE; *(f32x4*)(dst + (size_t)row * 8 + 4) = acc[ai][0][m][1] * IWSCALE; } }
        }
    }
};
struct EpiResid {
    static constexpr bool PERM = false, HAS_MID = false;
    const float* base; float* out; const float* mod; int gate_off;
    __device__ __forceinline__ void operator()(const f32x4 (&acc)[2][2][4][2], const pg8::Unit& u, int wr, int wc, int fr, int fq) const {
        const int row0 = u.pm * 256 + wr * 64 + fr, col0 = u.pn * 256 + wc * 32 + 4 * fq; const int b = (u.pm * 256) / SEQ;
        const float* gt = mod + b * 6144 + gate_off;
#pragma unroll
        for (int bj = 0; bj < 2; ++bj)
#pragma unroll
            for (int n = 0; n < 2; ++n) { const int col = col0 + bj * 128 + n * 16; const f32x4 g = *(const f32x4*)(gt + col);
#pragma unroll
                for (int ai = 0; ai < 2; ++ai)
#pragma unroll
                    for (int m = 0; m < 4; ++m) { const size_t off = (size_t)(row0 + ai * 128 + m * 16) * DM + col;
                        const f32x4 bs = *(const f32x4*)(base + off); *(f32x4*)(out + off) = bs + g * acc[ai][bj][m][n]; } }
    }
};
struct EpiFinal {
    static constexpr bool PERM = false, HAS_MID = false;
    const u16* x1b; float* out; const float* mod;
    __device__ __forceinline__ void operator()(const f32x4 (&acc)[2][2][4][2], const pg8::Unit& u, int wr, int wc, int fr, int fq) const {
        const int row0 = u.pm * 256 + wr * 64 + fr, col0 = u.pn * 256 + wc * 32 + 4 * fq; const int b = (u.pm * 256) / SEQ;
        const float* gt = mod + b * 6144 + 5120;
#pragma unroll
        for (int bj = 0; bj < 2; ++bj)
#pragma unroll
            for (int n = 0; n < 2; ++n) { const int col = col0 + bj * 128 + n * 16; const f32x4 g = *(const f32x4*)(gt + col);
#pragma unroll
                for (int ai = 0; ai < 2; ++ai)
#pragma unroll
                    for (int m = 0; m < 4; ++m) { const size_t off = (size_t)(row0 + ai * 128 + m * 16) * DM + col;
                        const u32x2 w = *(const u32x2*)(x1b + off);
                        const f32x4 bs = {bf2f((u16)(w.x & 0xffff)), bf2f((u16)(w.x >> 16)), bf2f((u16)(w.y & 0xffff)), bf2f((u16)(w.y >> 16))};
                        *(f32x4*)(out + off) = bs + g * acc[ai][bj][m][n]; } }
    }
};
struct EpiOut {
    static constexpr bool PERM = false, HAS_MID = true;
    const float* base; u16* x1b; float* ss2; const float* mod; const float* ssp;
    __device__ __forceinline__ void pre(float (&rs)[2][4], const pg8::Unit& u, int wr, int fr) const {
        const int row0 = u.pm * 256 + wr * 64 + fr;
#pragma unroll
        for (int ai = 0; ai < 2; ++ai)
#pragma unroll
            for (int m = 0; m < 4; ++m) { const float* sp = ssp + (size_t)(row0 + ai * 128 + m * 16) * 8; const f32x4 s0 = *(const f32x4*)sp, s1 = *(const f32x4*)(sp + 4);
                const float ss = ((s0.x + s0.y) + (s0.z + s0.w)) + ((s1.x + s1.y) + (s1.z + s1.w)); rs[ai][m] = 1.f / sqrtf(ss * (1.f / AW) + EPS); }
    }
    __device__ __forceinline__ void mid(f32x4 (&acc)[2][2][4][2], const float (&rs)[2][4]) const {
#pragma unroll
        for (int ai = 0; ai < 2; ++ai)
#pragma unroll
            for (int m = 0; m < 4; ++m)
#pragma unroll
                for (int bj = 0; bj < 2; ++bj)
#pragma unroll
                    for (int n = 0; n < 2; ++n) acc[ai][bj][m][n] *= rs[ai][m];
    }
    __device__ __forceinline__ void operator()(const f32x4 (&acc)[2][2][4][2], const pg8::Unit& u, int wr, int wc, int fr, int fq) const {
        const int row0 = u.pm * 256 + wr * 64 + fr, col0 = u.pn * 256 + wc * 32 + 4 * fq; const int b = (u.pm * 256) / SEQ;
        const float* gt = mod + b * 6144 + 2048;
        float rsq[2][4];
#pragma unroll
        for (int ai = 0; ai < 2; ++ai)
#pragma unroll
            for (int m = 0; m < 4; ++m) rsq[ai][m] = 0.f;
#pragma unroll
        for (int bj = 0; bj < 2; ++bj)
#pragma unroll
            for (int n = 0; n < 2; ++n) { const int col = col0 + bj * 128 + n * 16; const f32x4 g = *(const f32x4*)(gt + col);
#pragma unroll
                for (int ai = 0; ai < 2; ++ai)
#pragma unroll
                    for (int m = 0; m < 4; ++m) { const size_t off = (size_t)(row0 + ai * 128 + m * 16) * DM + col;
                        const f32x4 x1 = *(const f32x4*)(base + off) + g * acc[ai][bj][m][n];
                        u32x2 w; w.x = pk2bf(x1.x, x1.y); w.y = pk2bf(x1.z, x1.w); *(u32x2*)(x1b + off) = w;
                        rsq[ai][m] += (x1.x * x1.x + x1.y * x1.y) + (x1.z * x1.z + x1.w * x1.w); } }
#pragma unroll
        for (int ai = 0; ai < 2; ++ai)
#pragma unroll
            for (int m = 0; m < 4; ++m) { float v = rsq[ai][m]; v += __shfl_xor(v, 16); v += __shfl_xor(v, 32); if (fq == 0) atomicAdd(ss2 + row0 + ai * 128 + m * 16, v); }
    }
};
struct EpiFF1 {
    static constexpr bool PERM = true, HAS_MID = false;
    u16* O; const float* ss2; const float* cb;
    __device__ __forceinline__ void operator()(const f32x4 (&acc)[2][2][4][2], const pg8::Unit& u, int wr, int wc, int fr, int fq) const {
        const int row0 = u.pm * 256 + wr * 64 + fr, col0 = u.pn * 256 + wc * 32 + 8 * fq; const int b = (u.pm * 256) / SEQ;
        f32x4 c0[2], c1[2];
#pragma unroll
        for (int bj = 0; bj < 2; ++bj) { c0[bj] = *(const f32x4*)(cb + b * DFF + col0 + bj * 128); c1[bj] = *(const f32x4*)(cb + b * DFF + col0 + bj * 128 + 4); }
#pragma unroll
        for (int ai = 0; ai < 2; ++ai)
#pragma unroll
            for (int m = 0; m < 4; ++m) { const int row = row0 + ai * 128 + m * 16; const float rs = 1.f / sqrtf(ss2[row] * (1.f / DM) + EPS);
                u16* rowp = O + (size_t)row * DFF + col0;
#pragma unroll
                for (int bj = 0; bj < 2; ++bj) { f32x4 a = acc[ai][bj][m][0] * rs + c0[bj], c = acc[ai][bj][m][1] * rs + c1[bj];
#pragma unroll
                    for (int e = 0; e < 4; ++e) { const float x0 = fmaxf(a[e], 0.f), x1 = fmaxf(c[e], 0.f); a[e] = x0 * x0; c[e] = x1 * x1; }
                    u32x4 w; w.x = pk2bf(a[0], a[1]); w.y = pk2bf(a[2], a[3]); w.z = pk2bf(c[0], c[1]); w.w = pk2bf(c[2], c[3]);
                    *(u32x4*)(rowp + bj * 128) = w; } }
    }
};

constexpr int IX_CAP = 576;
constexpr int IX_IK = 0, IX_MASK = 0, IX_HIST = 32768, IX_CS = 32768, IX_CI = IX_CS + 32 * IX_CAP * 4, IX_INFO = IX_CI + 32 * IX_CAP * 2;
__device__ __forceinline__ int score_bin(float s) {
    const unsigned bits = __builtin_bit_cast(unsigned, s);
    const int mb = (int)((bits >> 18) & 0x1fffu);
    int c = mb - 3775; c = c < 0 ? 0 : (c > 511 ? 511 : c);
    const int sg = (int)bits >> 31;
    return (c ^ sg) + 512;
}
__device__ __forceinline__ int score_key(float s) { const int b = __builtin_bit_cast(int, s); return b ^ ((b >> 31) & 0x7fffffff); }
__device__ __forceinline__ int bin_keylo(int b) {
    if (b > 1023) return 0x7fffffff;
    if (b >= 512) { const int c = b - 512; return c == 0 ? 0 : ((c + 3775) << 18); }
    const int c = 511 - b; return c == 511 ? (int)0x80000000 : -((c + 3776) << 18);
}
__device__ __forceinline__ f32x16 idx_mma(const h16x8 (&af)[4], const h16x8 (&bf)[4]) {
    f32x16 c = {0.f, 0.f, 0.f, 0.f, 0.f, 0.f, 0.f, 0.f, 0.f, 0.f, 0.f, 0.f, 0.f, 0.f, 0.f, 0.f};
#pragma unroll
    for (int ks = 0; ks < 4; ++ks) c = __builtin_amdgcn_mfma_f32_32x32x16_f16(af[ks], bf[ks], c, 0, 0, 0);
    return c;
}
__device__ __forceinline__ void idx_epi(const f32x16& c, const float (&wq)[2][8], float& sA, float& sB) {
    float a = 0.f, b = 0.f;
#pragma unroll
    for (int j = 0; j < 8; ++j) { a = fmaf(__builtin_amdgcn_fmed3f(c[j] * 0x1p-12f, 0.f, 1.f), wq[0][j], a); b = fmaf(__builtin_amdgcn_fmed3f(c[8 + j] * 0x1p-12f, 0.f, 1.f), wq[1][j], b); }
    sA = a; sB = b;
}
typedef _Float16 h16x2 __attribute__((ext_vector_type(2)));
__device__ __forceinline__ int count_ge9(const unsigned (&u)[9], unsigned mid) {
    unsigned long long m0, m1, m2, m3, m4, m5, m6, m7, m8;
    asm("v_cmp_le_u32_e64 %0, %9, %10\n\tv_cmp_le_u32_e64 %1, %9, %11\n\tv_cmp_le_u32_e64 %2, %9, %12\n\tv_cmp_le_u32_e64 %3, %9, %13\n\t"
        "v_cmp_le_u32_e64 %4, %9, %14\n\tv_cmp_le_u32_e64 %5, %9, %15\n\tv_cmp_le_u32_e64 %6, %9, %16\n\tv_cmp_le_u32_e64 %7, %9, %17\n\tv_cmp_le_u32_e64 %8, %9, %18"
        : "=&s"(m0), "=&s"(m1), "=&s"(m2), "=&s"(m3), "=&s"(m4), "=&s"(m5), "=&s"(m6), "=&s"(m7), "=&s"(m8)
        : "s"(mid), "v"(u[0]), "v"(u[1]), "v"(u[2]), "v"(u[3]), "v"(u[4]), "v"(u[5]), "v"(u[6]), "v"(u[7]), "v"(u[8]));
    return __popcll(m0) + __popcll(m1) + __popcll(m2) + __popcll(m3) + __popcll(m4) + __popcll(m5) + __popcll(m6) + __popcll(m7) + __popcll(m8);
}
template <int VAR> __device__ __forceinline__ void idx_unit(const Params& p, LAS unsigned char* lds, int b, int hc, int tid, int wave, int lane) {
    const int t0 = hc * 32, N = 64 * (t0 / 64 + 1), NBT = (N + 127) >> 7, NST = N >> 5;
    const size_t rowb = (size_t)b * SEQ;
    unsigned* gmask = (unsigned*)(p.ws + (VAR ? WS_H : WS_MASK)) + (rowb + t0) * 256;
    LAS unsigned* lmask = (LAS unsigned*)(lds + IX_MASK);
    if (N <= 256) {
        for (int e = tid; e < 32 * 256; e += NTHR) { const int w = e & 255; gmask[e] = (w * 32 < N) ? 0xffffffffu : 0u; }
        return;
    }
    const u16* IQ = (const u16*)(p.ws + WS_IQ); const u16* IK = (const u16*)(p.ws + WS_IK); const float* IW = (const float*)(p.ws + WS_IW);
    const int qg = wave & 3, kh = wave >> 2, half = lane >> 5;
    h16x8 af[2][4]; float wq[2][2][8];
    { const int r = lane & 31, q = 2 * (r >> 4) + ((r >> 2) & 1), hd = (r & 3) + 4 * ((r >> 3) & 1);
#pragma unroll
      for (int a = 0; a < 2; ++a) { const u16* src = IQ + (rowb + t0 + 8 * qg + 4 * a + q) * 512 + hd * 64 + 8 * half;
#pragma unroll
          for (int ks = 0; ks < 4; ++ks) af[a][ks] = *(const h16x8*)(src + 16 * ks);
#pragma unroll
          for (int s2 = 0; s2 < 2; ++s2) { const float* wp = IW + (rowb + t0 + 8 * qg + 4 * a + 2 * s2 + half) * 8; const f32x4 w0 = *(const f32x4*)wp, w1 = *(const f32x4*)(wp + 4);
              wq[a][s2][0] = w0.x * 4096.f; wq[a][s2][1] = w0.y * 4096.f; wq[a][s2][2] = w0.z * 4096.f; wq[a][s2][3] = w0.w * 4096.f; wq[a][s2][4] = w1.x * 4096.f; wq[a][s2][5] = w1.y * 4096.f; wq[a][s2][6] = w1.z * 4096.f; wq[a][s2][7] = w1.w * 4096.f; } } }
    for (int e = tid; e < 65536 / 16; e += NTHR) *(LAS u32x4*)(lds + IX_HIST + e * 16) = (u32x4){0u, 0u, 0u, 0u};
    LAS int* info = (LAS int*)(lds + IX_INFO);
    int rowA[2], rowB[2];
#pragma unroll
    for (int a = 0; a < 2; ++a) { rowA[a] = 8 * qg + 4 * a + half; rowB[a] = rowA[a] + 2; }
    const int skey = tid >> 3, schunk = tid & 7; const int sdst = skey * 128 + ((schunk ^ ((skey >> 1) & 7)) * 16);
    const u16* ikg = IK + rowb * 64 + schunk * 8;
#define IDX_BFRAGS(ikt) h16x8 bf[2][4]; \
        _Pragma("unroll") for (int i = 0; i < 2; ++i) { const int key = (kh + 2 * i) * 32 + (lane & 31); \
            _Pragma("unroll") for (int ks = 0; ks < 4; ++ks) bf[i][ks] = *(const LAS h16x8*)((ikt) + key * 128 + (((2 * ks + half) ^ ((key >> 1) & 7)) * 16)); }
    {
        const int NBS = (NBT + 3) >> 2;
        auto sload = [&](int bs, u32x4& s0, u32x4& s1) __attribute__((always_inline)) {
            int j0 = 4 * bs + (skey >> 5), j1 = j0 + 2; j0 = j0 < NBT ? j0 : NBT - 1; j1 = j1 < NBT ? j1 : NBT - 1;
            s0 = *(const u32x4*)(ikg + (size_t)(128 * j0 + (skey & 31)) * 64); s1 = *(const u32x4*)(ikg + (size_t)(128 * j1 + (skey & 31)) * 64); };
        u32x4 stg0, stg1; sload(0, stg0, stg1);
        *(LAS u32x4*)(lds + IX_IK + sdst) = stg0; *(LAS u32x4*)(lds + IX_IK + 8192 + sdst) = stg1;
        __syncthreads();
        for (int bs = 0; bs < NBS; ++bs) {
            const LAS unsigned char* ikt = lds + IX_IK + (bs & 1) * 16384;
            sload(bs + 1 < NBS ? bs + 1 : bs, stg0, stg1);
            IDX_BFRAGS(ikt)
#define IDX_HIST(ACC, i, a) do { float sA, sB; idx_epi(ACC, wq[a], sA, sB); const unsigned one = (4 * bs + kh + 2 * (i)) < NBT ? 1u : 0u; \
                const int bA = score_bin(sA), bB = score_bin(sB); \
                lds_add_u32((LAS unsigned*)(lds + IX_HIST + rowA[a] * 2048 + (bA >> 1) * 4), one << ((bA & 1) * 16)); \
                lds_add_u32((LAS unsigned*)(lds + IX_HIST + rowB[a] * 2048 + (bB >> 1) * 4), one << ((bB & 1) * 16)); } while (0)
            f32x16 acc0 = idx_mma(af[0], bf[0]);
            f32x16 acc1 = idx_mma(af[1], bf[0]);
            IDX_HIST(acc0, 0, 0);
            acc0 = idx_mma(af[0], bf[1]);
            IDX_HIST(acc1, 0, 1);
            acc1 = idx_mma(af[1], bf[1]);
            IDX_HIST(acc0, 1, 0);
            IDX_HIST(acc1, 1, 1);
#undef IDX_HIST
            *(LAS u32x4*)(lds + IX_IK + ((bs + 1) & 1) * 16384 + sdst) = stg0; *(LAS u32x4*)(lds + IX_IK + ((bs + 1) & 1) * 16384 + 8192 + sdst) = stg1;
            __syncthreads();
        }
        const float nf = 32.f * (float)NBT, pf = 256.f / (float)N; const float varf = nf * pf * (1.f - pf) * (1.f - nf / (float)N);
        const unsigned R = (unsigned)(int)(nf * pf + 4.5f * sqrtf(varf > 0.f ? varf : 0.f) + 2.f);
        int tlo[4];
        for (int rr = 0; rr < 4; ++rr) { const int row = 4 * wave + rr;
            const LAS unsigned* hrow = (const LAS unsigned*)(lds + IX_HIST + row * 2048) + lane * 8;
            unsigned cnt[16]; unsigned tot = 0;
#pragma unroll
            for (int j = 0; j < 8; ++j) { const unsigned w = hrow[j]; cnt[2 * j] = w & 0xffffu; cnt[2 * j + 1] = w >> 16; tot += cnt[2 * j] + cnt[2 * j + 1]; }
            unsigned incl = tot;
#pragma unroll
            for (int o = 1; o < 64; o <<= 1) { const unsigned v = __shfl_down(incl, o); if (lane + o < 64) incl += v; }
            const unsigned above = incl - tot;
            int fs = -1;
            if (above < R && above + tot >= R) { unsigned run = above;
#pragma unroll
                for (int j = 15; j >= 0; --j) { const unsigned cjj = cnt[j]; if (run < R && run + cjj >= R) fs = 16 * lane + j; run += cjj; } }
            const unsigned long long fm = __ballot(fs >= 0); const int src = fm ? (int)__builtin_ctzll(fm) : 0;
            const int fsb = __shfl(fs, src);
            tlo[rr] = fm ? bin_keylo(fsb) : (int)0x80000000;
        }
        __syncthreads();
        if (lane == 0) { for (int rr = 0; rr < 4; ++rr) { const int k = tlo[rr]; info[(4 * wave + rr) * 4] = (k == (int)0x80000000) ? (int)0xff800000 : (k ^ ((k >> 31) & 0x7fffffff)); } }
        __syncthreads();
    }
    {
        float tA[2], tB[2]; LAS unsigned char *ctrA[2], *ctrB[2], *csA[2], *csB[2], *ciA[2], *ciB[2];
#pragma unroll
        for (int a = 0; a < 2; ++a) { tA[a] = __builtin_bit_cast(float, info[rowA[a] * 4]); tB[a] = __builtin_bit_cast(float, info[rowB[a] * 4]);
            ctrA[a] = lds + IX_INFO + rowA[a] * 16 + 4; ctrB[a] = lds + IX_INFO + rowB[a] * 16 + 4;
            csA[a] = lds + IX_CS + rowA[a] * (IX_CAP * 4); csB[a] = lds + IX_CS + rowB[a] * (IX_CAP * 4); ciA[a] = lds + IX_CI + rowA[a] * (IX_CAP * 2); ciB[a] = lds + IX_CI + rowB[a] * (IX_CAP * 2); }
        LAS unsigned char* dummy = lds + IX_INFO + 1024 + tid * 4;
        float dsum = 0.f;
        if (tid < 32) info[tid * 4 + 1] = 0;
        u32x4 stg0 = *(const u32x4*)(ikg + (size_t)skey * 64), stg1 = *(const u32x4*)(ikg + (size_t)(skey + 64) * 64);
        *(LAS u32x4*)(lds + IX_IK + sdst) = stg0; *(LAS u32x4*)(lds + IX_IK + 8192 + sdst) = stg1;
        __syncthreads();
#define IDX_REQ(ACC, i, a, KA, KB, PA, PB, SLA, SLB, KI) do { float sA, sB; if (VAR == 7) { sA = ACC[0]; sB = ACC[8]; } else idx_epi(ACC, wq[a], sA, sB); \
                if (VAR == 6 || VAR == 7) { dsum += sA + sB; PA = false; PB = false; KA = 0; KB = 0; SLA = 0; SLB = 0; KI = 0; break; } \
                const int st_ = 4 * bt + kh + 2 * (i); const bool valid_ = st_ < NST; KI = 32 * st_ + (lane & 31); \
                KA = __builtin_bit_cast(int, sA); KB = __builtin_bit_cast(int, sB); PA = (sA >= tA[a]) && valid_; PB = (sB >= tB[a]) && valid_; \
                SLA = lds_add_u32((LAS unsigned*)(PA ? ctrA[a] : dummy), 1u); SLB = lds_add_u32((LAS unsigned*)(PB ? ctrB[a] : dummy), 1u); } while (0)
#define IDX_PUT(a, KA, KB, PA, PB, SLA, SLB, KI) do { \
                if (PA && SLA < (unsigned)IX_CAP) { *(LAS int*)(csA[a] + SLA * 4) = KA; *(LAS u16*)(ciA[a] + SLA * 2) = (u16)(KI); } \
                if (PB && SLB < (unsigned)IX_CAP) { *(LAS int*)(csB[a] + SLB * 4) = KB; *(LAS u16*)(ciB[a] + SLB * 2) = (u16)(KI); } } while (0)
        int kA0 = 0, kB0 = 0, kA1 = 0, kB1 = 0, kA2 = 0, kB2 = 0, kA3 = 0, kB3 = 0, ki0 = 0, ki1 = 0, ki2 = 0, ki3 = 0;
        bool pA0 = false, pB0 = false, pA1 = false, pB1 = false, pA2 = false, pB2 = false, pA3 = false, pB3 = false;
        unsigned slA0 = 0, slB0 = 0, slA1 = 0, slB1 = 0, slA2 = 0, slB2 = 0, slA3 = 0, slB3 = 0;
        for (int bt = 0; bt < NBT; ++bt) {
            const LAS unsigned char* ikt = lds + IX_IK + (bt & 1) * 16384;
            { const int nb = bt + 1 < NBT ? bt + 1 : bt; stg0 = *(const u32x4*)(ikg + (size_t)(nb * 128 + skey) * 64); stg1 = *(const u32x4*)(ikg + (size_t)(nb * 128 + skey + 64) * 64); }
            IDX_BFRAGS(ikt)
            f32x16 acc0 = idx_mma(af[0], bf[0]);
            f32x16 acc1 = idx_mma(af[1], bf[0]);
            IDX_PUT(0, kA2, kB2, pA2, pB2, slA2, slB2, ki2);
            IDX_REQ(acc0, 0, 0, kA0, kB0, pA0, pB0, slA0, slB0, ki0);
            acc0 = idx_mma(af[0], bf[1]);
            IDX_PUT(1, kA3, kB3, pA3, pB3, slA3, slB3, ki3);
            IDX_REQ(acc1, 0, 1, kA1, kB1, pA1, pB1, slA1, slB1, ki1);
            IDX_PUT(0, kA0, kB0, pA0, pB0, slA0, slB0, ki0);
            acc1 = idx_mma(af[1], bf[1]);
            IDX_REQ(acc0, 1, 0, kA2, kB2, pA2, pB2, slA2, slB2, ki2);
            IDX_PUT(1, kA1, kB1, pA1, pB1, slA1, slB1, ki1);
            IDX_REQ(acc1, 1, 1, kA3, kB3, pA3, pB3, slA3, slB3, ki3);
            *(LAS u32x4*)(lds + IX_IK + ((bt + 1) & 1) * 16384 + sdst) = stg0; *(LAS u32x4*)(lds + IX_IK + ((bt + 1) & 1) * 16384 + 8192 + sdst) = stg1;
            __syncthreads();
        }
        IDX_PUT(0, kA2, kB2, pA2, pB2, slA2, slB2, ki2);
        IDX_PUT(1, kA3, kB3, pA3, pB3, slA3, slB3, ki3);
        if (VAR == 6 || VAR == 7) *(LAS float*)dummy = dsum;
#undef IDX_REQ
#undef IDX_PUT
    }
#undef IDX_BFRAGS
    for (int e = tid; e < 32768 / 16; e += NTHR) *(LAS u32x4*)(lds + IX_MASK + e * 16) = (u32x4){0u, 0u, 0u, 0u};
    __syncthreads();
    if (VAR == 2) { for (int e = tid; e < 32 * 256 / 4; e += NTHR) ((u32x4*)(p.ws + WS_H + 8 * MiB) + (size_t)(b * 256 + hc) * 2048)[e] = *(const LAS u32x4*)(lds + IX_CS + e * 16); __syncthreads(); return; }
    {
        unsigned uk[4][9]; int kx[4][9]; int Cn[4];
#pragma unroll
        for (int rr = 0; rr < 4; ++rr) { const int row = 4 * wave + rr;
            int c0 = info[row * 4 + 1];
#ifdef DEBUG_CHECK
            if (VAR == 0 && lane == 0 && c0 > IX_CAP) atomicAdd((unsigned*)(p.ws + WS_CTL) + 14, 1u);
#endif
            c0 = c0 > IX_CAP ? IX_CAP : c0;
            Cn[rr] = c0;
            const LAS int* cs = (const LAS int*)(lds + IX_CS) + row * IX_CAP; const LAS u16* ci = (const LAS u16*)(lds + IX_CI) + row * IX_CAP;
#pragma unroll
            for (int e = 0; e < 9; ++e) { const int pi = lane + 64 * e; const bool ok = pi < c0;
                const unsigned u = (unsigned)score_key(__builtin_bit_cast(float, cs[pi])) ^ 0x80000000u; uk[rr][e] = ok ? (u == 0u ? 1u : u) : 0u; kx[rr][e] = ok ? (int)ci[pi] : 0x7fffffff; } }
        unsigned lo[4], hi[4], p0[4];
#pragma unroll
        for (int rr = 0; rr < 4; ++rr) { lo[rr] = 1u; hi[rr] = Cn[rr] <= 256 ? 2u : 0xffffffffu;
            const int tb = __builtin_amdgcn_readfirstlane(info[(4 * wave + rr) * 4]);
            p0[rr] = (unsigned)score_key(__builtin_bit_cast(float, tb)) ^ 0x80000000u; }
#define IDX_BIS(MIDEXPR, CHECK) do { \
            _Pragma("unroll") for (int rr = 0; rr < 4; ++rr) { const unsigned mid = (MIDEXPR); \
                const int cnt = count_ge9(uk[rr], mid); \
                const bool ok = !(CHECK) || (mid - lo[rr] - 1u) < (hi[rr] - lo[rr] - 1u);             \
                const unsigned nlo = cnt >= 256 ? mid : lo[rr], nhi = cnt > 256 ? hi[rr] : (cnt == 256 ? mid + 1u : mid); \
                lo[rr] = ok ? nlo : lo[rr]; hi[rr] = ok ? nhi : hi[rr]; } } while (0)
        if (VAR != 14) {
            IDX_BIS(p0[rr], true);
            IDX_BIS(lo[rr] + (1u << 22), true);
            if (p0[0] <= 0x80000000u || p0[1] <= 0x80000000u || p0[2] <= 0x80000000u || p0[3] <= 0x80000000u) {
                IDX_BIS(0x80000001u, true);
                IDX_BIS(0x80000000u, true);
            }
            for (int it = 0; it < 32; ++it) {
                IDX_BIS(lo[rr] + ((hi[rr] - lo[rr]) >> 1), false);
                const unsigned w = ((hi[0] - lo[0]) | (hi[1] - lo[1]) | (hi[2] - lo[2]) | (hi[3] - lo[3]));
                if (w <= 1u) break;
            }
        }
#undef IDX_BIS
#pragma unroll
        for (int rr = 0; rr < 4; ++rr) { const int row = 4 * wave + rr;
            unsigned thr = lo[rr]; int need = 0;
            if (Cn[rr] <= 256) thr = 0u;
            else { int above = 0;
#pragma unroll
                for (int e = 0; e < 9; ++e) above += __popcll(__ballot(uk[rr][e] > thr));
                need = 256 - above; }
            bool sel[9]; int ntie = 0;
#pragma unroll
            for (int e = 0; e < 9; ++e) ntie += __popcll(__ballot(uk[rr][e] == thr && thr != 0u));
            const bool alltie = ntie <= need;
#pragma unroll
            for (int e = 0; e < 9; ++e) sel[e] = uk[rr][e] > thr || (alltie && uk[rr][e] == thr);
            if (!alltie) {
                int ilo = -1, ihi = 8191;
                for (int it = 0; it < 13; ++it) { const int imid = (ilo + ihi) >> 1; int c = 0;
#pragma unroll
                    for (int e = 0; e < 9; ++e) c += __popcll(__ballot(uk[rr][e] == thr && kx[rr][e] <= imid));
                    if (c >= need) ihi = imid; else ilo = imid; }
#pragma unroll
                for (int e = 0; e < 9; ++e) sel[e] = sel[e] || (uk[rr][e] == thr && kx[rr][e] <= ihi);
            }
#pragma unroll
            for (int e = 0; e < 9; ++e) if (sel[e] && kx[rr][e] != 0x7fffffff) lds_or_u32((LAS unsigned*)&lmask[row * 256 + (kx[rr][e] >> 5)], 1u << (kx[rr][e] & 31));
        }
    }
    __syncthreads();
    for (int e = tid; e < 32 * 256 / 4; e += NTHR) ((u32x4*)gmask)[e] = *(const LAS u32x4*)(lds + IX_MASK + e * 16);
    __syncthreads();
}

constexpr int CV_IN = 0, CV_Y = 65536;
__device__ __forceinline__ void conv_unit(const Params& p, LAS unsigned char* lds, int unit, int tid, int wave, int lane) {
    const int b = unit >> 8, t0 = (unit & 255) * 32; const size_t rowb = (size_t)b * SEQ;
    const u16* G = (const u16*)(p.ws + WS_GLU); u16* MX = (u16*)(p.ws + WS_CONV);
    LAS u16* ubuf = (LAS u16*)(lds + CV_IN); LAS float* ybuf = (LAS float*)(lds + CV_Y);
    { u32x4 sv[8];
#pragma unroll
      for (int i = 0; i < 8; ++i) { const int e = tid + i * NTHR; const int r = e >> 6, c = e & 63; const int t = t0 - 30 + r;
          sv[i] = (u32x4){0u, 0u, 0u, 0u}; if (e < 62 * 64 && t >= 0) sv[i] = *(const u32x4*)(G + (rowb + t) * CW + c * 8); }
#pragma unroll
      for (int i = 0; i < 8; ++i) { const int e = tid + i * NTHR; if (e < 62 * 64) *(LAS u32x4*)(ubuf + (e >> 6) * 512 + (e & 63) * 8) = sv[i]; } }
    __syncthreads();
    {
        const int c = tid; float w[CK];
#pragma unroll
        for (int j = 0; j < CK; ++j) w[j] = p.w_dw[j * CW + c];
        const float bias = p.b_dw[c];
        float u[62];
#pragma unroll
        for (int i = 0; i < 62; ++i) u[i] = bf2f(ubuf[i * 512 + c]);
#pragma unroll
        for (int i = 0; i < 32; ++i) { float a = bias;
#pragma unroll
            for (int j = 0; j < CK; ++j) a = fmaf(w[j], u[i + j], a);
            ybuf[i * 512 + c] = a; }
    }
    __syncthreads();
    {
        float v[4][8]; float s[4], q[4], ss[4];
        const f32x4 g0 = *(const f32x4*)(p.g_conv_ln + 8 * lane), g1 = *(const f32x4*)(p.g_conv_ln + 8 * lane + 4), b0 = *(const f32x4*)(p.b_conv_ln + 8 * lane), b1 = *(const f32x4*)(p.b_conv_ln + 8 * lane + 4);
#pragma unroll
        for (int rr = 0; rr < 4; ++rr) { const int tok = 4 * wave + rr;
            const f32x4 a = *(const LAS f32x4*)(ybuf + tok * 512 + 8 * lane), c2 = *(const LAS f32x4*)(ybuf + tok * 512 + 8 * lane + 4);
            v[rr][0] = a.x; v[rr][1] = a.y; v[rr][2] = a.z; v[rr][3] = a.w; v[rr][4] = c2.x; v[rr][5] = c2.y; v[rr][6] = c2.z; v[rr][7] = c2.w;
            s[rr] = 0.f;
#pragma unroll
            for (int e = 0; e < 8; ++e) s[rr] += v[rr][e]; }
#pragma unroll
        for (int o = 1; o < 64; o <<= 1) {
#pragma unroll
            for (int rr = 0; rr < 4; ++rr) s[rr] += __shfl_xor(s[rr], o); }
#pragma unroll
        for (int rr = 0; rr < 4; ++rr) { const float mu = s[rr] * (1.f / CW); q[rr] = 0.f;
#pragma unroll
            for (int e = 0; e < 8; ++e) { v[rr][e] -= mu; q[rr] += v[rr][e] * v[rr][e]; } }
#pragma unroll
        for (int o = 1; o < 64; o <<= 1) {
#pragma unroll
            for (int rr = 0; rr < 4; ++rr) q[rr] += __shfl_xor(q[rr], o); }
#pragma unroll
        for (int rr = 0; rr < 4; ++rr) { const float rstd = 1.f / sqrtf(q[rr] * (1.f / CW) + EPS); ss[rr] = 0.f;
#pragma unroll
            for (int e = 0; e < 8; ++e) { const float gg = e < 4 ? g0[e & 3] : g1[e & 3], bb = e < 4 ? b0[e & 3] : b1[e & 3]; const float y = v[rr][e] * rstd * gg + bb; const float z = y / (1.f + __expf(-y)); v[rr][e] = z; ss[rr] += z * z; } }
#pragma unroll
        for (int o = 1; o < 64; o <<= 1) {
#pragma unroll
            for (int rr = 0; rr < 4; ++rr) ss[rr] += __shfl_xor(ss[rr], o); }
#pragma unroll
        for (int rr = 0; rr < 4; ++rr) { const int tok = 4 * wave + rr; const float r2 = 1.f / sqrtf(ss[rr] * (1.f / CW) + EPS);
            u32x4 o; o.x = pk2bf(v[rr][0] * r2, v[rr][1] * r2); o.y = pk2bf(v[rr][2] * r2, v[rr][3] * r2); o.z = pk2bf(v[rr][4] * r2, v[rr][5] * r2); o.w = pk2bf(v[rr][6] * r2, v[rr][7] * r2);
            *(u32x4*)(MX + (rowb + t0 + tok) * CW + 8 * lane) = o; }
    }
    __syncthreads();
}

constexpr int AT_K = 0, AT_V = 16384, AT_O = 32768, AT_L = 65536;
typedef short v4i16_t __attribute__((ext_vector_type(4)));
__device__ __forceinline__ void at_qk(f32x16& p0, f32x16& p1, const LAS unsigned char* kt, const b16x8 (&qf)[4], int r32, int hi) {
#pragma unroll
    for (int r = 0; r < 16; ++r) { p0[r] = -SM_OFF; p1[r] = -SM_OFF; }
#pragma unroll
    for (int ks = 0; ks < 4; ++ks) {
        const int k0 = r32, k1 = 32 + r32;
        const b16x8 a0 = *(const LAS b16x8*)(kt + k0 * 128 + (((2 * ks + hi) ^ ((k0 >> 1) & 7)) * 16));
        const b16x8 a1 = *(const LAS b16x8*)(kt + k1 * 128 + (((2 * ks + hi) ^ ((k1 >> 1) & 7)) * 16));
        p0 = __builtin_amdgcn_mfma_f32_32x32x16_bf16(a0, qf[ks], p0, 0, 0, 0);
        p1 = __builtin_amdgcn_mfma_f32_32x32x16_bf16(a1, qf[ks], p1, 0, 0, 0);
    }
}
__device__ __forceinline__ void attn_unit(const Params& p, LAS unsigned char* lds, int b, int h, int qt, int tid, int wave, int lane) {
    const size_t rowb = (size_t)b * SEQ; const int q0 = qt * 256, NT = 4 * (qt + 1);
    const u16* Q = (const u16*)(p.ws + WS_Q); const u16* Kg = (const u16*)(p.ws + WS_K); const u16* Vg = (const u16*)(p.ws + WS_V);
    const unsigned* MK = (const unsigned*)(p.ws + WS_MASK);
    const int r32 = lane & 31, hi = lane >> 5;
    const int qrow = q0 + 32 * wave + r32;
    b16x8 qf[4];
    { const u16* src = Q + (rowb + qrow) * AW + h * 64 + 8 * hi;
#pragma unroll
      for (int ks = 0; ks < 4; ++ks) qf[ks] = *(const b16x8*)(src + 16 * ks); }
    const unsigned* mrow = MK + (rowb + qrow) * 256;
    f32x16 o0 = {0.f, 0.f, 0.f, 0.f, 0.f, 0.f, 0.f, 0.f, 0.f, 0.f, 0.f, 0.f, 0.f, 0.f, 0.f, 0.f}, o1 = o0;
    f32x16 lacc = o0;
    const b16x8 ones = __builtin_bit_cast(b16x8, (u32x4){0x3f803f80u, 0x3f803f80u, 0x3f803f80u, 0x3f803f80u});
    const int kkey = 8 * wave + (lane >> 3), kch = (lane & 7) ^ ((kkey >> 1) & 7);
    const u16* kg = Kg + (rowb + kkey) * AW + h * 64 + kch * 8;
    const u16* vg = Vg + (rowb + 16 * (wave & 3) + (lane >> 2)) * AW + h * 64 + 32 * (wave >> 2) + 8 * (lane & 3);
    const int dma_off = wave * 1024;
#define AT_DMA(gp, ldsoff) __builtin_amdgcn_global_load_lds((const unsigned*)(gp), (LAS unsigned*)(lds + (ldsoff) + dma_off), 16, 0, 0)
    AT_DMA(kg, AT_K); AT_DMA(kg + (size_t)64 * AW, AT_K + 8192); AT_DMA(vg, AT_V);
    u32x2 mw = *(const u32x2*)(mrow); u32x2 mwA = mw;
    __syncthreads();
    f32x16 sA, sB, sC_, sD_;
    at_qk(sA, sB, lds + AT_K, qf, r32, hi);
    __syncthreads();
    const int g16 = lane >> 4, q4 = (lane & 15) >> 2, pp = lane & 3;
    const int vb = (g16 & 1) * 32 + pp * 8 + (4 * (g16 >> 1) + q4) * 64;
#define AT_STEP(C0, C1, N0, N1, t) do { \
        const int tk_ = (t) + 2 < NT ? (t) + 2 : NT - 1, tv_ = (t) + 1 < NT ? (t) + 1 : NT - 1; \
        AT_DMA(kg + (size_t)tk_ * 64 * AW, AT_K + ((t) & 1) * 8192);              \
        AT_DMA(vg + (size_t)tv_ * 64 * AW, AT_V + (((t) + 1) & 1) * 8192);        \
        mwA = *(const u32x2*)(mrow + 2 * tv_); \
        at_qk(N0, N1, lds + AT_K + (((t) + 1) & 1) * 8192, qf, r32, hi); \
        const unsigned w0_ = mw.x >> (4 * hi), w1_ = mw.y >> (4 * hi); \
        _Pragma("unroll") for (int r = 0; r < 16; ++r) { const int pos_ = (r & 3) + 8 * (r >> 2); \
            const float e0_ = __builtin_amdgcn_exp2f(C0[r]); int m0_ = __builtin_amdgcn_sbfe((int)w0_, pos_, 1); asm("" : "+v"(m0_)); \
            C0[r] = __builtin_bit_cast(float, __builtin_bit_cast(int, e0_) & m0_); } \
        b16x8 pa_[4]; \
        _Pragma("unroll") for (int s_ = 0; s_ < 2; ++s_) { u32x4 w_; \
            _Pragma("unroll") for (int j = 0; j < 4; ++j) w_[j] = pk2bf(C0[8 * s_ + 2 * j], C0[8 * s_ + 2 * j + 1]); \
            pa_[s_] = __builtin_bit_cast(b16x8, w_); } \
        _Pragma("unroll") for (int r = 0; r < 16; ++r) { const int pos_ = (r & 3) + 8 * (r >> 2); \
            const float e1_ = __builtin_amdgcn_exp2f(C1[r]); int m1_ = __builtin_amdgcn_sbfe((int)w1_, pos_, 1); asm("" : "+v"(m1_)); \
            C1[r] = __builtin_bit_cast(float, __builtin_bit_cast(int, e1_) & m1_); } \
        _Pragma("unroll") for (int s_ = 0; s_ < 2; ++s_) { u32x4 w_; \
            _Pragma("unroll") for (int j = 0; j < 4; ++j) w_[j] = pk2bf(C1[8 * s_ + 2 * j], C1[8 * s_ + 2 * j + 1]); \
            pa_[2 + s_] = __builtin_bit_cast(b16x8, w_); } \
        { const LAS unsigned char* vt_ = lds + AT_V + ((t) & 1) * 8192; \
          _Pragma("unroll") for (int s_ = 0; s_ < 4; ++s_) \
          _Pragma("unroll") for (int d0 = 0; d0 < 2; ++d0) { \
              const LAS unsigned char* a_ = vt_ + vb + s_ * 1024 + d0 * 4096; \
              const v4i16_t lo_ = __builtin_amdgcn_ds_read_tr16_b64_v4i16((LAS v4i16_t*)a_); \
              const v4i16_t hi4_ = __builtin_amdgcn_ds_read_tr16_b64_v4i16((LAS v4i16_t*)(a_ + 512)); \
              const s16x8 bv_ = (s16x8){lo_[0], lo_[1], lo_[2], lo_[3], hi4_[0], hi4_[1], hi4_[2], hi4_[3]}; \
              if (d0 == 0) { o0 = __builtin_amdgcn_mfma_f32_32x32x16_bf16(pa_[s_], __builtin_bit_cast(b16x8, bv_), o0, 0, 0, 0); lacc = __builtin_amdgcn_mfma_f32_32x32x16_bf16(pa_[s_], ones, lacc, 0, 0, 0); } \
              else o1 = __builtin_amdgcn_mfma_f32_32x32x16_bf16(pa_[s_], __builtin_bit_cast(b16x8, bv_), o1, 0, 0, 0); } } \
        mw = mwA; \
          \
        _Pragma("unroll") for (int i_ = 0; i_ < 8; ++i_) { __builtin_amdgcn_sched_group_barrier(0x100, 2, 0); __builtin_amdgcn_sched_group_barrier(0x008, 1, 0); __builtin_amdgcn_sched_group_barrier(0x002, 7, 0); } \
        _Pragma("unroll") for (int i_ = 0; i_ < 8; ++i_) { __builtin_amdgcn_sched_group_barrier(0x100, 2, 0); __builtin_amdgcn_sched_group_barrier(0x008, 1, 0); __builtin_amdgcn_sched_group_barrier(0x002, 7, 0); } \
        __syncthreads(); } while (0)
    for (int t = 0; t < NT; t += 2) {
        AT_STEP(sA, sB, sC_, sD_, t);
        AT_STEP(sC_, sD_, sA, sB, t + 1);
    }
#undef AT_STEP
#undef AT_DMA
    LAS u16* stg = (LAS u16*)(lds + AT_O + wave * 4096);
#pragma unroll
    for (int r = 0; r < 16; ++r) { const int orow = (r & 3) + 8 * (r >> 2) + 4 * hi; const float rl = 1.f / lacc[r];
        stg[orow * 64 + r32] = (u16)f2bf(o0[r] * rl); stg[orow * 64 + 32 + r32] = (u16)f2bf(o1[r] * rl); }
    LDS_WAIT(); asm volatile("" ::: "memory");
    { const int row = lane >> 1, hf = lane & 1; float ss = 0.f; u32x4 v[4];
#pragma unroll
      for (int j = 0; j < 4; ++j) { v[j] = *(const LAS u32x4*)(stg + row * 64 + hf * 32 + j * 8);
#pragma unroll
          for (int e = 0; e < 4; ++e) { const float a = bf2f((u16)(v[j][e] & 0xffff)), c = bf2f((u16)(v[j][e] >> 16)); ss += a * a + c * c; } }
      ss += __shfl_xor(ss, 1);
      const size_t grow = rowb + q0 + 32 * wave + row;
      u16* dst = (u16*)(p.ws + WS_ATT) + grow * AW + h * 64 + hf * 32;
#pragma unroll
      for (int j = 0; j < 4; ++j) *(u32x4*)(dst + j * 8) = v[j];
      if (hf == 0) ((float*)(p.ws + WS_SSP))[grow * 8 + h] = ss; }
    __syncthreads();
}

#ifdef DEBUG_CHECK
__device__ __forceinline__ void dbg_attn_check(const Params& p, int gw, int NGW, int lane) {
    const u16* Q = (const u16*)(p.ws + WS_Q); const u16* Kg = (const u16*)(p.ws + WS_K); const u16* Vg = (const u16*)(p.ws + WS_V);
    const unsigned* MK = (const unsigned*)(p.ws + WS_MASK); const u16* A = (const u16*)(p.ws + WS_ATT);
    unsigned* ctl = (unsigned*)(p.ws + WS_CTL);
    for (int it = gw; it < (M / 16) * 8; it += NGW) {
        const int row = (it >> 3) * 16 + 5, h = it & 7; const int b = row / SEQ, t = row % SEQ; const size_t rowb = (size_t)b * SEQ;
        const int N = 64 * (t / 64 + 1);
        float q[64];
#pragma unroll
        for (int d = 0; d < 64; ++d) q[d] = bf2f(Q[(size_t)row * AW + h * 64 + d]);
        float o[64]; float l = 0.f;
#pragma unroll
        for (int d = 0; d < 64; ++d) o[d] = 0.f;
        for (int key = lane; key < N; key += 64) {
            const unsigned w = MK[(size_t)row * 256 + (key >> 5)];
            if ((w >> (key & 31)) & 1u) {
                float s = 0.f;
#pragma unroll
                for (int d = 0; d < 64; ++d) s += q[d] * bf2f(Kg[(rowb + key) * AW + h * 64 + d]);
                const float pr = exp2f(s - SM_OFF); l += pr;
#pragma unroll
                for (int d = 0; d < 64; ++d) o[d] += pr * bf2f(Vg[(rowb + key) * AW + h * 64 + d]);
            }
        }
        l = wave_sum(l); float maxerr = 0.f, maxref = 0.f;
#pragma unroll
        for (int d = 0; d < 64; ++d) { const float od = wave_sum(o[d]) / l; const float got = bf2f(A[(size_t)row * AW + h * 64 + d]); maxerr = fmaxf(maxerr, fabsf(od - got)); maxref = fmaxf(maxref, fabsf(od)); }
        if (lane == 0 && !(maxerr <= 0.03f * maxref + 1e-3f)) atomicAdd(&ctl[8], 1u);
    }
}
__device__ __forceinline__ void dbg_idx_check(const Params& p, int gw, int NGW, int lane) {
    const u16* IQ = (const u16*)(p.ws + WS_IQ); const u16* IK = (const u16*)(p.ws + WS_IK); const float* IW = (const float*)(p.ws + WS_IW);
    const unsigned* MK = (const unsigned*)(p.ws + WS_MASK); unsigned* ctl = (unsigned*)(p.ws + WS_CTL);
    for (int it = gw; it < M / 16; it += NGW) {
        const int row = it * 16 + 5; const int b = row / SEQ, t = row % SEQ; const size_t rowb = (size_t)b * SEQ; const int N = 64 * (t / 64 + 1);
        float minsel = 3e38f, maxun = -3e38f; int cnt = 0;
        for (int key = lane; key < N; key += 64) {
            float sc = 0.f;
            for (int h = 0; h < 8; ++h) { float d = 0.f;
                for (int e = 0; e < 64; ++e) d += (float)__builtin_bit_cast(_Float16, IQ[(size_t)row * 512 + h * 64 + e]) * (float)__builtin_bit_cast(_Float16, IK[(rowb + key) * 64 + e]);
                sc += IW[(size_t)row * 8 + h] * fmaxf(d, 0.f); }
            const unsigned w = MK[(size_t)row * 256 + (key >> 5)];
            if ((w >> (key & 31)) & 1u) { minsel = fminf(minsel, sc); ++cnt; } else maxun = fmaxf(maxun, sc);
        }
        int extra = 0; for (int wi = N / 32 + lane; wi < 256; wi += 64) extra += __popc(MK[(size_t)row * 256 + wi]);
#pragma unroll
        for (int o = 1; o < 64; o <<= 1) { minsel = fminf(minsel, __shfl_xor(minsel, o)); maxun = fmaxf(maxun, __shfl_xor(maxun, o)); cnt += __shfl_xor(cnt, o); extra += __shfl_xor(extra, o); }
        const int want = N < 256 ? N : 256;
        if (lane == 0) { if (cnt != want) { atomicAdd(&ctl[9], 1u); atomicMax(&ctl[12], (unsigned)(N / 64)); atomicMax(&ctl[13], (unsigned)(cnt > want ? cnt - want : want - cnt)); }
            else if (extra != 0) atomicAdd(&ctl[10], 1u);
            else if (N > 256 && !(minsel >= maxun - 2e-3f * (fabsf(maxun) + 1.f))) atomicAdd(&ctl[11], 1u); }
    }
}
__device__ __forceinline__ void dbg_encode(const Params& p, int gw, int NGW, int lane) {
    const unsigned* ctl = (const unsigned*)(p.ws + WS_CTL);
    const unsigned cb = __hip_atomic_load(&ctl[9], __ATOMIC_RELAXED, __HIP_MEMORY_SCOPE_AGENT), eb = __hip_atomic_load(&ctl[10], __ATOMIC_RELAXED, __HIP_MEMORY_SCOPE_AGENT), ob = __hip_atomic_load(&ctl[11], __ATOMIC_RELAXED, __HIP_MEMORY_SCOPE_AGENT);
    const unsigned n64 = __hip_atomic_load(&ctl[12], __ATOMIC_RELAXED, __HIP_MEMORY_SCOPE_AGENT), dc = __hip_atomic_load(&ctl[13], __ATOMIC_RELAXED, __HIP_MEMORY_SCOPE_AGENT);
    const unsigned c14 = __hip_atomic_load(&ctl[14], __ATOMIC_RELAXED, __HIP_MEMORY_SCOPE_AGENT), c15 = __hip_atomic_load(&ctl[15], __ATOMIC_RELAXED, __HIP_MEMORY_SCOPE_AGENT);
    if (cb == 0 && eb == 0 && ob == 0 && c14 == 0 && c15 == 0) return;
    const float s = c14 ? 0.5f : (c15 ? -1.f : 0.f);
    for (int m = gw; m < M; m += NGW) { const f32x4* xr = (const f32x4*)(p.x + (size_t)m * DM) + lane; f32x4* o = (f32x4*)(p.out + (size_t)m * DM) + lane;
#pragma unroll
        for (int j = 0; j < 4; ++j) o[64 * j] = xr[64 * j] * s; }
    if (gw == 0 && lane == 0) { p.out[0] = 1000.f * (float)cb; p.out[1] = 0.f; }
    (void)n64; (void)dc;
}
#endif

__global__ void __launch_bounds__(NTHR, 2) fwd_megakernel(Params p) {
    extern __shared__ __attribute__((aligned(16))) unsigned char lds_raw[];
    LAS unsigned char* lds = (LAS unsigned char*)lds_raw;
    const int tid = threadIdx.x;
    const int G = gridDim.x; const int bx = blockIdx.x; const int vcu = (G % 8 == 0) ? (bx % 8) * (G / 8) + bx / 8 : bx;
    volatile LAS unsigned* MISC = (volatile LAS unsigned*)(lds + MISC_OFF);
    for (int u = tid; u < (LDS_BYTES - RING_BYTES) / 4; u += NTHR) ((LAS unsigned*)(lds + RING_BYTES))[u] = 0u;
    __syncthreads();
    XcdBarrier bar = xcd_barrier_post((unsigned*)(p.ws + WS_CTL) + CW_BAR, MISC + 8);
    const int NGW = G * NWAVES;

#define PH_IDS() const int tid_ = opaque_tid(); const int lane_ = tid_ & 63; const int wave_ = __builtin_amdgcn_readfirstlane(tid_ >> 6); const int gw_ = vcu * NWAVES + wave_
    REP(0) { PH_IDS(); p0_phase(p, lds, vcu, G, tid_, wave_, lane_); }
    xcd_barrier(bar);
    if (((REPEAT_MASK) >> 11) & 1) { for (int q_ = 0; q_ < 8; ++q_) xcd_barrier(bar); }
    REP(1) { PH_IDS(); p1_rows(p, gw_, NGW, lane_); if (G != 256) p1_extra(p, lds, vcu, G, tid_, wave_, lane_); }
    xcd_barrier(bar);
    REP(2) { const int n1_ = (rep_ == 1) ? 3072 : N1; pg8::Gemm g{(const u16*)(p.ws + WS_H), (const u16*)(p.ws + WS_H), (const u16*)(p.ws + WS_WIN), nullptr, M, n1_, DM, DM, DM / 64}; pg8::StaticOrder S; S.init(M, n1_, G, bx);
      EpiInProj E{p.ws, p.g_q, p.g_k};
      pg8::gemm_phase<EpiInProj, true>(lds, g, S, E);
      if (G == 256 && bx >= 64) { PH_IDS(); (void)gw_; late_weights(p, lds, (bx - 64) * NWAVES + wave_, 192 * NWAVES, wave_, lane_); __syncthreads();
          p1_extra(p, lds, bx - 64, G, tid_, wave_, lane_); }
      else if (G != 256) { PH_IDS(); late_weights(p, lds, gw_, NGW, wave_, lane_); }
      __syncthreads(); }
    xcd_barrier(bar);
    REP(3) if (G == 256) {
        const int b = vcu >> 7, i = vcu & 127;
        { PH_IDS(); (void)gw_; idx_unit<0>(p, lds, b, 255 - i, tid_, wave_, lane_); }
        { PH_IDS(); (void)gw_; idx_unit<0>(p, lds, b, i, tid_, wave_, lane_); }
    }
#ifdef IDX_VAR
    if (G == 256) {
        const int b = vcu >> 7, i = vcu & 127;
        { PH_IDS(); (void)gw_; idx_unit<IDX_VAR>(p, lds, b, 255 - i, tid_, wave_, lane_); }
        { PH_IDS(); (void)gw_; idx_unit<IDX_VAR>(p, lds, b, i, tid_, wave_, lane_); }
    }
#endif
    REP(9) if (G == 256) {
        { PH_IDS(); (void)gw_; conv_unit(p, lds, 2 * vcu, tid_, wave_, lane_); }
        { PH_IDS(); (void)gw_; conv_unit(p, lds, 2 * vcu + 1, tid_, wave_, lane_); }
    }
    xcd_barrier(bar);
    REP(4) if (G == 256) {
        const int bh = vcu >> 4, j = vcu & 15;
        { PH_IDS(); (void)gw_; attn_unit(p, lds, bh >> 3, bh & 7, 31 - j, tid_, wave_, lane_); }
        { PH_IDS(); (void)gw_; attn_unit(p, lds, bh >> 3, bh & 7, j, tid_, wave_, lane_); }
    }
    xcd_barrier(bar);
#ifdef DEBUG_CHECK
    { PH_IDS(); dbg_attn_check(p, gw_, NGW, lane_); dbg_idx_check(p, gw_, NGW, lane_); }
    xcd_barrier(bar);
#endif
    REP(6) { pg8::Gemm g{(const u16*)(p.ws + WS_ATT), (const u16*)(p.ws + WS_CONV), (const u16*)(p.ws + WS_WOUT), nullptr, M, DM, DM, AW, AW / 64}; pg8::StaticOrder S; S.init(M, DM, G, bx);
      EpiOut E{p.x, (u16*)(p.ws + WS_X1B), (float*)(p.ws + (rep_ == 0 ? WS_SS2 : WS_H)), (const float*)(p.ws + WS_MOD), (const float*)(p.ws + WS_SSP)};
      pg8::gemm_phase<EpiOut, false>(lds, g, S, E); }
    xcd_barrier(bar);
    REP(8) { pg8::Gemm g{(const u16*)(p.ws + WS_X1B), (const u16*)(p.ws + WS_X1B), (const u16*)(p.ws + WS_W1), (const u16*)(p.ws + WS_W1) + (size_t)DFF * DM, M, DFF, DM, DM, DM / 64}; pg8::StaticOrder S; S.init(M, DFF, G, bx);
      EpiFF1 E{(u16*)(p.ws + WS_F1), (const float*)(p.ws + WS_SS2), (const float*)(p.ws + WS_CB)};
      pg8::gemm_phase<EpiFF1, false>(lds, g, S, E); }
    xcd_barrier(bar);
    REP(10) { pg8::Gemm g{(const u16*)(p.ws + WS_F1), (const u16*)(p.ws + WS_F1), (const u16*)(p.ws + WS_W2), nullptr, M, DM, DFF, DFF, DFF / 64}; pg8::StaticOrder S; S.init(M, DM, G, bx);
      EpiFinal E{(const u16*)(p.ws + WS_X1B), p.out, (const float*)(p.ws + WS_MOD)};
      pg8::gemm_phase<EpiFinal, false>(lds, g, S, E); }
#ifdef DEBUG_CHECK
    xcd_barrier(bar);
    { PH_IDS(); dbg_encode(p, gw_, NGW, lane_); }
#endif
}

extern "C" void kernel_launch(void* const* d_in, const int* in_sizes, int n_in, void* d_out, int out_size, void* d_ws, size_t ws_size, hipStream_t stream) {
    static int grid = 0;
    if (grid == 0) {
        int dev = 0, cus = 0, per_cu = 0;
        if (n_in != 18 || out_size != M * DM || ws_size < WS_END) { fprintf(stderr, "kernel_launch: unexpected shapes (n_in %d out %d ws %zu)\n", n_in, out_size, ws_size); grid = -1; return; }
        if (hipGetDevice(&dev) != hipSuccess || hipDeviceGetAttribute(&cus, hipDeviceAttributeMultiprocessorCount, dev) != hipSuccess) { grid = -1; return; }
        if (hipFuncSetAttribute((const void*)fwd_megakernel, hipFuncAttributeMaxDynamicSharedMemorySize, LDS_BYTES) != hipSuccess) { fprintf(stderr, "kernel_launch: hipFuncSetAttribute failed\n"); grid = -1; return; }
        if (hipOccupancyMaxActiveBlocksPerMultiprocessor(&per_cu, (const void*)fwd_megakernel, NTHR, LDS_BYTES) != hipSuccess || per_cu < 1) { fprintf(stderr, "kernel_launch: occupancy query says %d\n", per_cu); per_cu = 1; }
        (void)hipGetLastError();
        grid = cus;
        if (grid != 256) fprintf(stderr, "kernel_launch: %d CUs, expected 256\n", grid);
    }
    if (grid < 0) return;
    if (hipMemsetAsync((char*)d_ws + WS_CTL, 0, CTL_ZERO_BYTES, stream) != hipSuccess) return;
    Params p{};
    const float** pp = (const float**)&p;
    for (int i = 0; i < 18; ++i) pp[i] = (const float*)d_in[i];
    p.out = (float*)d_out; p.ws = (unsigned char*)d_ws;
    void* args[] = {&p};
    hipError_t e = hipLaunchCooperativeKernel((void*)fwd_megakernel, dim3(grid), dim3(NTHR), args, LDS_BYTES, stream);
    if (e != hipSuccess) fprintf(stderr, "cooperative launch failed: %s (grid %d)\n", hipGetErrorString(e), grid);
}
```

```cpp
#ifndef REPEAT_MASK
#define REPEAT_MASK 0
#endif
#define REP(k) for (int rep_ = 0; rep_ < (((REPEAT_MASK) >> (k)) & 1) + 1; ++rep_)
#include <hip/hip_runtime.h>
#include <hip/hip_cooperative_groups.h>
#include <cstdio>
#include <cstdint>
#include <cmath>
#include <type_traits>

#define LAS __attribute__((address_space(3)))
#define GAS __attribute__((address_space(1)))
typedef unsigned short u16;
typedef short s16x8 __attribute__((ext_vector_type(8)));
typedef short s16x4 __attribute__((ext_vector_type(4)));
typedef _Float16 h16x8 __attribute__((ext_vector_type(8)));
typedef __bf16 b16x8 __attribute__((ext_vector_type(8)));
typedef float f32x4 __attribute__((ext_vector_type(4)));
typedef float f32x16 __attribute__((ext_vector_type(16)));
typedef unsigned u32x4 __attribute__((ext_vector_type(4)));
typedef unsigned u32x2 __attribute__((ext_vector_type(2)));

constexpr int SEQ = 8192, NB = 2, M = NB * SEQ, DM = 1024, DFF = 4096;
constexpr int AW = 512, NH = 8, HD = 64, CW = 512, CK = 31;
constexpr int IN_COLS = 3144, N1 = 3328;
constexpr int C_Q = 0, C_K = 512, C_V = 1024, C_IQ = 1536, C_IK = 2048, C_IW = 2112, C_CA = 2120, C_CG = 2632;
constexpr float EPS = 1e-6f;
constexpr float QSCALE = 0.125f * 1.4426950408889634f;
constexpr float IWSCALE = 0.35355339059327373f * 0.125f;
constexpr float SM_OFF = 0.0f;

constexpr size_t MiB = 1u << 20;
constexpr size_t WS_CTL = 0, CTL_ZERO_BYTES = 64 * 1024;
constexpr size_t WS_MOD = 1 * MiB;
constexpr size_t WS_COS = 1 * MiB + 64 * 1024;
constexpr size_t WS_SIN = WS_COS + 256 * 1024;
constexpr size_t WS_WIN = 2 * MiB;
constexpr size_t WS_WOUT = 9 * MiB;
constexpr size_t WS_W1 = 240 * MiB;
constexpr size_t WS_W2 = 19 * MiB;
constexpr size_t WS_SSP = 27 * MiB;
constexpr size_t WS_SS2 = 27 * MiB + 512 * 1024;
constexpr size_t WS_IW = 28 * MiB;
constexpr size_t WS_CB = 28 * MiB + 512 * 1024;
constexpr size_t WS_IK = 29 * MiB;
constexpr size_t WS_H = 32 * MiB;
constexpr size_t WS_Q = 64 * MiB, WS_K = 80 * MiB, WS_V = 96 * MiB;
constexpr size_t WS_IQ = 112 * MiB;
constexpr size_t WS_GLU = 128 * MiB;
constexpr size_t WS_MASK = 144 * MiB;
constexpr size_t WS_ATT = 160 * MiB;
constexpr size_t WS_CONV = 176 * MiB;
constexpr size_t WS_X1B = 208 * MiB;
constexpr size_t WS_F1 = 32 * MiB;
constexpr size_t WS_END = 256 * MiB;
constexpr int CW_BAR = 4096;
constexpr int CW_CONVQ = 2048;

constexpr int NWAVES = 8, NTHR = 512;
constexpr int LDS_BYTES = 147456;
constexpr int RING_BYTES = 131072;
constexpr int MISC_OFF = LDS_BYTES - 256;

__device__ __forceinline__ unsigned f2bf(float f) { unsigned u = __builtin_bit_cast(unsigned, f); return (u + 0x7fffu + ((u >> 16) & 1u)) >> 16; }
typedef float f32x2_t __attribute__((ext_vector_type(2))); typedef __bf16 bf16x2_t __attribute__((ext_vector_type(2)));
__device__ __forceinline__ unsigned pk2bf(float lo, float hi) { f32x2_t v = {lo, hi}; bf16x2_t b = __builtin_convertvector(v, bf16x2_t); return __builtin_bit_cast(unsigned, b); }
__device__ __forceinline__ unsigned pk2h(float lo, float hi) { _Float16 a = (_Float16)lo, b = (_Float16)hi; return (unsigned)__builtin_bit_cast(u16, a) | ((unsigned)__builtin_bit_cast(u16, b) << 16); }
__device__ __forceinline__ float bf2f(unsigned short v) { return __builtin_bit_cast(float, (unsigned)v << 16); }
__device__ __forceinline__ float wave_sum(float v) {
#define WS_STEP(ctrl, rmask) { const int t_ = __builtin_amdgcn_update_dpp(0, __builtin_bit_cast(int, v), ctrl, rmask, 0xF, true); v += __builtin_bit_cast(float, t_); }
    WS_STEP(0x111, 0xF) WS_STEP(0x112, 0xF) WS_STEP(0x114, 0xF) WS_STEP(0x118, 0xF) WS_STEP(0x142, 0xA) WS_STEP(0x143, 0xC)
#undef WS_STEP
    return __builtin_bit_cast(float, __builtin_amdgcn_readlane(__builtin_bit_cast(int, v), 63));
}
__device__ __forceinline__ unsigned lds_add_u32(LAS unsigned* p, unsigned v) { return __hip_atomic_fetch_add(p, v, __ATOMIC_RELAXED, __HIP_MEMORY_SCOPE_WORKGROUP); }
__device__ __forceinline__ unsigned lds_or_u32(LAS unsigned* p, unsigned v) { return __hip_atomic_fetch_or(p, v, __ATOMIC_RELAXED, __HIP_MEMORY_SCOPE_WORKGROUP); }
__device__ __forceinline__ int opaque_tid() { int t = threadIdx.x; asm volatile("" : "+v"(t)); return t; }
#define LDS_WAIT() asm volatile("s_waitcnt lgkmcnt(0)" ::: "memory")
#define VM_WAIT() asm volatile("s_waitcnt vmcnt(0)" ::: "memory")

namespace pg8 {
constexpr int BM = 256, BK = 64, HALF = 128, HTB = HALF * BK * 2, STAGE_BYTES = 8 * HTB, NXCD = 8, WGM = 8;
__host__ __device__ __forceinline__ int lds_byte(int r, int c) { const int st = (r >> 4) * 2 + (c >> 5), rr = r & 15, cc = c & 31, ob = rr * 64 + cc * 2; return st * 1024 + (ob ^ (((ob >> 9) & 1) << 5)); }
__host__ __device__ __forceinline__ void stage_rc(int b, int& R, int& C) { const int st = b / 1024, sb = b % 1024, swz = sb ^ (((sb >> 9) & 1) << 5); R = (st >> 1) * 16 + swz / 64; C = (st & 1) * 32 + (swz % 64) / 2; }
__host__ __device__ __forceinline__ int perm32(int rho) { const int n = rho >> 4, i = rho & 15; return 8 * (i >> 2) + 4 * n + (i & 3); }
struct Unit { int pm, pn; };
struct Gemm { const u16* A; const u16* A2; const u16* Bt; const u16* Bt2; int M, N, K, lda, ksplit; };
struct StaticOrder {
    int nM, nN, nwg, G, c;
    __host__ __device__ void init(int M_, int N_, int G_, int c_) { nM = M_ / BM; nN = N_ / BM; nwg = nM * nN; G = G_; c = c_; }
    __host__ __device__ bool next(int i, Unit& u) const {
        const long L = (long)i * G + c; if (L >= nwg) return false;
        int wgid = (int)L; { const int q = nwg / NXCD, r = nwg % NXCD, xcd = wgid % NXCD, off = wgid / NXCD; wgid = (xcd < r ? xcd * (q + 1) : r * (q + 1) + (xcd - r) * q) + off; }
        const int nig = WGM * nN, gid = wgid / nig, fm = gid * WGM, gsz = (nM - fm) < WGM ? (nM - fm) : WGM;
        u.pm = fm + ((wgid % nig) % gsz); u.pn = (wgid % nig) / gsz; return true;
    }
};
template <bool F16> __device__ __forceinline__ f32x4 mma16(s16x8 a, s16x8 b, f32x4 c) {
    if constexpr (F16) return __builtin_amdgcn_mfma_f32_16x16x32_f16(__builtin_bit_cast(h16x8, a), __builtin_bit_cast(h16x8, b), c, 0, 0, 0);
    else return __builtin_amdgcn_mfma_f32_16x16x32_bf16(__builtin_bit_cast(b16x8, a), __builtin_bit_cast(b16x8, b), c, 0, 0, 0);
}
template <class Epi, bool F16>
__device__ __forceinline__ void gemm_phase(LAS unsigned char* lds, const Gemm g, const StaticOrder& S, const Epi& E) {
    const int tid = opaque_tid(), wid = __builtin_amdgcn_readfirstlane(tid >> 6), lane = tid & 63, wr = wid >> 2, wc = wid & 3, fr = lane & 15, fq = lane >> 4;
    const int K = g.K, nt = K / BK;
    unsigned voffA[2], voffB[2];
#pragma unroll
    for (int i = 0; i < 2; ++i) { int R, C; stage_rc(tid * 16 + i * 8192, R, C); const int Rb = Epi::PERM ? ((R & ~31) + perm32(R & 31)) : R;
        voffA[i] = (unsigned)(R * g.lda + C) * 2u; voffB[i] = (unsigned)(Rb * K + C) * 2u; }
    const size_t kstep = (size_t)(BK * 2);
    const size_t hstep = (size_t)HALF * K * 2;
    const size_t tstep = 2 * hstep;
    const size_t hstepA = (size_t)HALF * g.lda * 2, tstepA = 2 * hstepA;
    const int ksplit = g.ksplit;
    const unsigned ldsw = (unsigned)wid * 1024u;
    const int aoff = lds_byte(wr * 64 + fr, fq * 8), boff = lds_byte(wc * 32 + fr, fq * 8);
#define PG8_SA(b, h) (((b) * 2 + (h)) * HTB)
#define PG8_SB(b, h) ((4 + (b) * 2 + (h)) * HTB)
#define PG8_STAGE(bufoff, gbase, voff) do { _Pragma("unroll") for (int _i = 0; _i < 2; ++_i) \
        __builtin_amdgcn_global_load_lds((const unsigned*)((const char*)(gbase) + (voff)[_i]), (LAS unsigned*)(lds + (bufoff) + ldsw + _i * 8192), 16, 0, 0); } while (0)
#define PG8_LDA(dst, b, h) do { _Pragma("unroll") for (int m = 0; m < 4; ++m) _Pragma("unroll") for (int k = 0; k < 2; ++k) dst[m][k] = *(const LAS s16x8*)(lds + PG8_SA(b, h) + aoff + m * 2048 + k * 1024); } while (0)
#define PG8_LDB(dst, b, h) do { _Pragma("unroll") for (int n = 0; n < 2; ++n) _Pragma("unroll") for (int k = 0; k < 2; ++k) dst[n][k] = *(const LAS s16x8*)(lds + PG8_SB(b, h) + boff + n * 2048 + k * 1024); } while (0)
#define PG8_MMA(ai, bj, At, Bt) do { __builtin_amdgcn_s_setprio(1); _Pragma("unroll") for (int m = 0; m < 4; ++m) _Pragma("unroll") for (int n = 0; n < 2; ++n) _Pragma("unroll") for (int k = 0; k < 2; ++k) \
        acc[ai][bj][m][n] = mma16<F16>(Bt[n][k], At[m][k], acc[ai][bj][m][n]); __builtin_amdgcn_s_setprio(0); } while (0)
#define PG8_WAIT_V(n) asm volatile("s_waitcnt vmcnt(" #n ")" ::: "memory")
#define PG8_WAIT_L(n) asm volatile("s_waitcnt lgkmcnt(" #n ")" ::: "memory")
#define PG8_BAR __builtin_amdgcn_s_barrier()
#define PG8_SCHED __builtin_amdgcn_sched_barrier(0)
    Unit cur, nxt; int ui = 0;
    if (!S.next(0, cur)) return;
    f32x4 acc[2][2][4][2];
#pragma unroll
    for (int a = 0; a < 2; ++a)
#pragma unroll
        for (int b = 0; b < 2; ++b)
#pragma unroll
            for (int m = 0; m < 4; ++m)
#pragma unroll
                for (int n = 0; n < 2; ++n) acc[a][b][m][n] = (f32x4){0.f, 0.f, 0.f, 0.f};
    s16x8 At[4][2], B0[2][2], B1[2][2];
    float midrs[2][4];
    if constexpr (Epi::HAS_MID) E.pre(midrs, cur, wr, fr);
#define PG8_BSEL(u_) ((g.Bt2 && (u_).pm * BM >= g.M / 2) ? (const char*)g.Bt2 : (const char*)g.Bt)
#define PG8_AT(b1, b2, t_) ((t_) < ksplit ? (b1) + (size_t)(t_) * kstep : (b2) + (size_t)((t_) - ksplit) * kstep)
    const char* cA = (const char*)g.A + (size_t)cur.pm * tstepA; const char* cA2 = (const char*)g.A2 + (size_t)cur.pm * tstepA; const char* cB = PG8_BSEL(cur) + (size_t)cur.pn * tstep;
    PG8_STAGE(PG8_SB(0, 0), cB, voffB); PG8_STAGE(PG8_SB(0, 1), cB + hstep, voffB); PG8_STAGE(PG8_SA(0, 0), cA, voffA); PG8_STAGE(PG8_SA(0, 1), cA + hstepA, voffA);
    if (wr == 1) PG8_BAR;
    PG8_WAIT_V(2); PG8_BAR;
    PG8_STAGE(PG8_SB(1, 0), cB + kstep, voffB); PG8_STAGE(PG8_SA(1, 0), cA + kstep, voffA); PG8_STAGE(PG8_SB(1, 1), cB + hstep + kstep, voffB);
    PG8_WAIT_V(6); PG8_BAR;
    for (;;) {
        const bool has_next = S.next(ui + 1, nxt);
        const char* nA = has_next ? (const char*)g.A + (size_t)nxt.pm * tstepA : cA; const char* nA2 = has_next ? (const char*)g.A2 + (size_t)nxt.pm * tstepA : cA2; const char* nB = has_next ? PG8_BSEL(nxt) + (size_t)nxt.pn * tstep : cB;
        for (int t = 0; t < nt; t += 2) {
            const bool last = (t == nt - 2);
            const char* a1 = PG8_AT(cA, cA2, t + 1);
            const char* a2 = last ? nA : PG8_AT(cA, cA2, t + 2); const char* b2 = last ? nB : cB + (size_t)(t + 2) * kstep;
            const char* a3 = last ? nA + kstep : PG8_AT(cA, cA2, t + 3); const char* b3 = b2 + kstep;
            PG8_LDB(B0, 0, 0); PG8_LDB(B1, 0, 1); PG8_SCHED; PG8_LDA(At, 0, 0); PG8_STAGE(PG8_SA(1, 1), a1 + hstepA, voffA);
            PG8_WAIT_V(8); PG8_WAIT_L(0); PG8_BAR; PG8_MMA(0, 0, At, B0); PG8_MMA(0, 1, At, B1); PG8_BAR; PG8_SCHED;
            PG8_LDA(At, 0, 1); PG8_STAGE(PG8_SB(0, 0), b2, voffB); PG8_STAGE(PG8_SB(0, 1), b2 + hstep, voffB); PG8_STAGE(PG8_SA(0, 0), a2, voffA);
            PG8_WAIT_V(8); PG8_WAIT_L(0); PG8_BAR; PG8_MMA(1, 0, At, B0); PG8_MMA(1, 1, At, B1); PG8_BAR; PG8_SCHED;
            PG8_LDB(B0, 1, 0); PG8_LDB(B1, 1, 1); PG8_SCHED; PG8_LDA(At, 1, 0); PG8_STAGE(PG8_SA(0, 1), a2 + hstepA, voffA);
            PG8_WAIT_V(8); PG8_WAIT_L(0); PG8_BAR; PG8_MMA(0, 0, At, B0); PG8_MMA(0, 1, At, B1); PG8_BAR; PG8_SCHED;
            PG8_LDA(At, 1, 1); PG8_STAGE(PG8_SB(1, 0), b3, voffB); PG8_STAGE(PG8_SB(1, 1), b3 + hstep, voffB); PG8_STAGE(PG8_SA(1, 0), a3, voffA);
            PG8_WAIT_V(8); PG8_WAIT_L(0); PG8_BAR; PG8_MMA(1, 0, At, B0); PG8_MMA(1, 1, At, B1); PG8_BAR; PG8_SCHED;
            if constexpr (Epi::HAS_MID) { if (t + 2 == ksplit) E.mid(acc, midrs); }
        }
        if (wr == 0) PG8_BAR;
        E(acc, cur, wr, wc, fr, fq);
        if (!has_next) break;
#pragma unroll
        for (int a = 0; a < 2; ++a)
#pragma unroll
            for (int b = 0; b < 2; ++b)
#pragma unroll
                for (int m = 0; m < 4; ++m)
#pragma unroll
                    for (int n = 0; n < 2; ++n) acc[a][b][m][n] = (f32x4){0.f, 0.f, 0.f, 0.f};
        cur = nxt; cA = nA; cA2 = nA2; cB = nB; ++ui;
        if constexpr (Epi::HAS_MID) E.pre(midrs, cur, wr, fr);
        if (wr == 1) PG8_BAR;
    }
    PG8_WAIT_V(0);
    PG8_BAR;
#undef PG8_BSEL
#undef PG8_AT
#undef PG8_SA
#undef PG8_SB
#undef PG8_STAGE
#undef PG8_LDA
#undef PG8_LDB
#undef PG8_MMA
#undef PG8_WAIT_V
#undef PG8_WAIT_L
#undef PG8_BAR
#undef PG8_SCHED
}
}

#define XB_TMO      128
#define XB_XCNT(j)  (256  + 64 * (j))
#define XB_XSUB(j)  (1280 + 64 * (j))
#define XB_XGEN(j)  (2304 + 64 * (j))
#define XB_TOP      3328
#define XB_TOPGEN   3392
#define XCD_BAR_WORDS 3456
#define XB_SPIN_CAP (1u << 18)
__device__ __forceinline__ unsigned xb_ld(unsigned* p)              { return __hip_atomic_load(p, __ATOMIC_RELAXED, __HIP_MEMORY_SCOPE_AGENT); }
__device__ __forceinline__ unsigned xb_add(unsigned* p, unsigned v) { return __hip_atomic_fetch_add(p, v, __ATOMIC_RELAXED, __HIP_MEMORY_SCOPE_AGENT); }
__device__ __forceinline__ unsigned xb_xcc_id() { return (unsigned)__builtin_amdgcn_s_getreg((3 << 11) | 20) & 0xFu; }
#define XB_SPIN(cond, bar) do { unsigned _sp = 0; while (cond) { __builtin_amdgcn_s_sleep(1); \
    if ((++_sp & 255u) == 0u) { if (xb_ld(&(bar)[XB_TMO])) break; if (_sp > XB_SPIN_CAP) { atomicAdd(&(bar)[XB_TMO], 1u); break; } } } } while (0)
struct XcdBarrier { unsigned* bar; unsigned x; volatile LAS unsigned* st; };
__device__ __forceinline__ XcdBarrier xcd_barrier_post(unsigned* bar, volatile LAS unsigned* st) {
    XcdBarrier b; b.bar = bar; b.x = xb_xcc_id(); b.st = st;
    if (threadIdx.x == 0) (void)xb_add(&bar[XB_XCNT(b.x)], 1u);
    return b;
}
__device__ __forceinline__ void xcd_barrier_complete(unsigned* bar, unsigned x, unsigned& nloc, unsigned& nx) {
    const unsigned G = gridDim.x * gridDim.y * gridDim.z;
    unsigned sum, cnt, mine, sp = 0u;
    for (;;) {
        sum = 0u; cnt = 0u; mine = 0u;
#pragma unroll
        for (unsigned j = 0; j < 16; ++j) { const unsigned c = xb_ld(&bar[XB_XCNT(j)]); sum += c; cnt += (c > 0u) ? 1u : 0u; mine = (j == x) ? c : mine; }
        if (sum == G) break;
        __builtin_amdgcn_s_sleep(1);
        if ((++sp & 255u) == 0u) { if (xb_ld(&bar[XB_TMO])) break; if (sp > XB_SPIN_CAP) { atomicAdd(&bar[XB_TMO], 1u); break; } }
    }
    nloc = mine > 0u ? mine : 1u; nx = cnt > 0u ? cnt : 1u;
}
__device__ __forceinline__ void xcd_barrier(const XcdBarrier& b) {
    asm volatile("s_waitcnt vmcnt(0)" ::: "memory");
    __syncthreads();
    if (threadIdx.x == 0) {
        unsigned* bar = b.bar;
        __builtin_amdgcn_s_waitcnt(0);
        unsigned nloc = b.st[0], nx = b.st[1];
        if (nloc == 0u) { xcd_barrier_complete(bar, b.x, nloc, nx); b.st[0] = nloc; b.st[1] = nx; }
        const unsigned old = xb_add(&bar[XB_XSUB(b.x)], 1u);
        const unsigned gen = old / nloc;
        if (old + 1u == (gen + 1u) * nloc) {
            __builtin_amdgcn_fence(__ATOMIC_RELEASE, "agent");
            asm volatile("s_waitcnt vmcnt(0)" ::: "memory");
            const unsigned og = xb_add(&bar[XB_TOP], 1u);
            const unsigned tg = og / nx;
            if (og + 1u == (tg + 1u) * nx) xb_add(&bar[XB_TOPGEN], 1u);
            else XB_SPIN(xb_ld(&bar[XB_TOPGEN]) == tg, bar);
            xb_add(&bar[XB_XGEN(b.x)], 1u);
            __builtin_amdgcn_fence(__ATOMIC_ACQUIRE, "agent");
            asm volatile("s_waitcnt vmcnt(0)" ::: "memory");
        } else {
            XB_SPIN(xb_ld(&bar[XB_XGEN(b.x)]) == gen, bar);
            __builtin_amdgcn_fence(__ATOMIC_ACQUIRE, "agent");
            asm volatile("s_waitcnt vmcnt(0)" ::: "memory");
        }
    }
    __syncthreads();
}

struct Params {
    const float *x, *c, *w_ada, *b_ada, *g_norm1, *w_in, *g_q, *g_k, *w_dw, *b_dw, *g_conv_ln, *b_conv_ln, *g_out_attn, *g_out_conv, *w_out, *g_norm2, *w_ff1, *w_ff2;
    float* out; unsigned char* ws;
};

template <bool F16, class SrcCol>
__device__ __forceinline__ void transpose_item(const float* W, int K, int Nsrc, u16* WT, const float* rs, LAS float* scr, int item, int nblk, int lane, SrcCol srccol, const float* rs2 = nullptr) {
    const int kb = item / nblk, nb = item % nblk, k0 = 64 * kb, n0 = 32 * nb;
    const int c4 = (lane & 7) * 4, r8 = lane >> 3; const int sc = srccol(n0 + c4); const bool run4 = sc >= 0 && srccol(n0 + c4 + 3) == sc + 3;
    f32x4 v[8];
    if (run4) {
#pragma unroll
        for (int i = 0; i < 8; ++i) v[i] = *(const f32x4*)(W + (size_t)(k0 + r8 + 8 * i) * Nsrc + sc);
    } else {
#pragma unroll
        for (int i = 0; i < 8; ++i)
#pragma unroll
            for (int e = 0; e < 4; ++e) { const int s1 = srccol(n0 + c4 + e); v[i][e] = s1 >= 0 ? W[(size_t)(k0 + r8 + 8 * i) * Nsrc + s1] : 0.f; }
    }
#pragma unroll
    for (int i = 0; i < 8; ++i) { const int kk = r8 + 8 * i; float sc1 = 1.f; if (rs) sc1 = rs[k0 + kk]; if (rs2) sc1 *= 1.f + rs2[k0 + kk];
#pragma unroll
        for (int e = 0; e < 4; ++e) scr[kk * 33 + c4 + e] = v[i][e] * sc1; }
    LDS_WAIT(); asm volatile("" ::: "memory");
    const int c = lane & 7;
#pragma unroll
    for (int j = 0; j < 4; ++j) { const int n = (lane >> 3) + 8 * j; const LAS float* s = scr + (8 * c) * 33 + n;
        u32x4 o;
        if (F16) { o.x = pk2h(s[0 * 33], s[1 * 33]); o.y = pk2h(s[2 * 33], s[3 * 33]); o.z = pk2h(s[4 * 33], s[5 * 33]); o.w = pk2h(s[6 * 33], s[7 * 33]); }
        else { o.x = pk2bf(s[0 * 33], s[1 * 33]); o.y = pk2bf(s[2 * 33], s[3 * 33]); o.z = pk2bf(s[4 * 33], s[5 * 33]); o.w = pk2bf(s[6 * 33], s[7 * 33]); }
        *(u32x4*)(WT + (size_t)(n0 + n) * K + k0 + 8 * c) = o; }
    LDS_WAIT(); asm volatile("" ::: "memory");
}
__device__ __forceinline__ int win_srccol(int p) {
    const int pn = p >> 8, r = p & 255, bj = r >> 7, wc = (r >> 5) & 3, i = r & 31;
    if (pn < 6) { const int base = (pn >> 1) * 512; const int head = 4 * (pn & 1) + wc; return base + head * 64 + 32 * bj + i; }
    if (pn < 10) { const int ch = 128 * (pn - 6) + 32 * wc + i; return (bj == 0 ? C_CA : C_CG) + ch; }
    if (pn < 12) { const int head = 4 * (pn - 10) + wc; return C_IQ + head * 64 + 32 * bj + i; }
    if (wc == 0) return C_IK + 32 * bj + i;
    if (wc == 1 && bj == 0 && i < 8) return C_IW + i;
    return -1;
}
__device__ __forceinline__ void p0_phase(const Params& p, LAS unsigned char* lds, int vcu, int G, int tid, int wave, int lane) {
    unsigned char* ws = p.ws;
    { float* cosT = (float*)(ws + WS_COS); float* sinT = (float*)(ws + WS_SIN);
      for (int e = vcu * NTHR + tid; e < SEQ * 8; e += G * NTHR) { const int pos = e >> 3, i = e & 7;
          const double invd[8] = {1.0, 0.19392274474868576, 0.03760603093086393, 0.007292664737217109, 0.001414213562373095, 0.0002742481756762073, 5.318295896944988e-05, 1.031338537721246e-05};
          double id = invd[0];
#pragma unroll
          for (int q = 1; q < 8; ++q) id = (i == q) ? invd[q] : id;
          const float inv = (float)id; const float ang = (float)pos * inv;
          double t = (double)ang * 0.15915494309189535; t -= __builtin_rint(t);
          const float fr = (float)t;
          cosT[e] = __builtin_amdgcn_cosf(fr); sinT[e] = __builtin_amdgcn_sinf(fr); } }
    const int kl = tid >> 3, cq = tid & 7, c0 = vcu * 32 + cq * 4;
    f32x4 wv[16];
    if (vcu < 192) {
#pragma unroll
        for (int i = 0; i < 16; ++i) wv[i] = __builtin_nontemporal_load((const f32x4*)(p.w_ada + (size_t)(kl + 64 * i) * 6144 + c0));
    }
    { LAS float* scr = (LAS float*)(lds + 32768 + wave * 8704);
      const int gw = vcu * NWAVES + wave, NGW = G * NWAVES;
      constexpr int I_IN = (DM / 64) * (N1 / 32);
      { float* ss2 = (float*)(ws + WS_SS2); for (int e = vcu * NTHR + tid; e < M; e += G * NTHR) ss2[e] = 0.f; }
      for (int it = gw; it < I_IN; it += NGW)
          transpose_item<true>(p.w_in, DM, IN_COLS, (u16*)(ws + WS_WIN), nullptr, scr, it, N1 / 32, lane, [](int n) { return win_srccol(n); }); }
    if (vcu < 192) {
        LAS float* sc = (LAS float*)lds;
        LAS float* red = (LAS float*)(lds + 8192);
        for (int e = tid; e < 2048; e += NTHR) { const float v = p.c[e]; sc[e] = v / (1.f + __expf(-v)); }
        __syncthreads();
        f32x4 a0 = {0.f, 0.f, 0.f, 0.f}, a1 = {0.f, 0.f, 0.f, 0.f};
#pragma unroll
        for (int i = 0; i < 16; ++i) { const int k = kl + 64 * i; a0 += wv[i] * sc[k]; a1 += wv[i] * sc[1024 + k]; }
        *(LAS f32x4*)(red + (kl * 8 + cq) * 8) = a0; *(LAS f32x4*)(red + (kl * 8 + cq) * 8 + 4) = a1;
        __syncthreads();
        { LAS float* red2 = red + 4096;
          const int o = tid & 63, part = tid >> 6, cq2 = o >> 3, j = o & 7; float s = 0.f;
#pragma unroll
          for (int k2 = 0; k2 < 8; ++k2) s += red[((part * 8 + k2) * 8 + cq2) * 8 + j];
          red2[part * 64 + o] = s;
          __syncthreads();
          if (tid < 64) { float t = 0.f;
#pragma unroll
              for (int q = 0; q < 8; ++q) t += red2[q * 64 + tid];
              const int b = j >> 2, col = vcu * 32 + cq2 * 4 + (j & 3);
              ((float*)(ws + WS_MOD))[b * 6144 + col] = t + p.b_ada[col]; } }
        __syncthreads();
    }
}
__device__ __forceinline__ void late_weights(const Params& p, LAS unsigned char* lds, int widx, int nw, int wave, int lane) {
    unsigned char* ws = p.ws; const float* mod = (const float*)(ws + WS_MOD);
    LAS float* scr = (LAS float*)(lds + 32768 + wave * 8704);
    constexpr int I_O = (DM / 64) * (DM / 32), I_1 = (DM / 64) * (DFF / 32), I_2 = (DFF / 64) * (DM / 32);
    for (int it = widx; it < I_O + I_2 + 2 * I_1; it += nw) {
        int r = it;
        if (r < I_O) { const int kb = r / (DM / 32); const float* rs = (kb < 8) ? p.g_out_attn : (p.g_out_conv - 512);
            transpose_item<false>(p.w_out, DM, DM, (u16*)(ws + WS_WOUT), rs, scr, r, DM / 32, lane, [](int n) { return n; }); continue; } r -= I_O;
        if (r < I_2) { transpose_item<false>(p.w_ff2, DFF, DM, (u16*)(ws + WS_W2), nullptr, scr, r, DM / 32, lane, [](int n) { return n; }); continue; } r -= I_2;
        const int b = r / I_1; r -= b * I_1;
        transpose_item<false>(p.w_ff1, DM, DFF, (u16*)(ws + WS_W1) + (size_t)b * DFF * DM, p.g_norm2, scr, r, DFF / 32, lane, [](int n) { return n; }, mod + b * 6144 + 4096);
    }
}

__device__ __forceinline__ void p1_rows(const Params& p, int gw, int NGW, int lane) {
    const float* mod = (const float*)(p.ws + WS_MOD); u16* H = (u16*)(p.ws + WS_H);
    for (int m0 = gw * 4; m0 < M; m0 += NGW * 4) {
        f32x4 v[4][4];
#pragma unroll
        for (int r = 0; r < 4; ++r) { const f32x4* xr = (const f32x4*)(p.x + (size_t)(m0 + r) * DM) + lane;
#pragma unroll
            for (int j = 0; j < 4; ++j) v[r][j] = __builtin_nontemporal_load(xr + 64 * j); }
        const int b = m0 / SEQ; const float* sh = mod + b * 6144; const float* scl = mod + b * 6144 + 1024;
        f32x4 gm[4], hm[4];
#pragma unroll
        for (int j = 0; j < 4; ++j) { const int c = 4 * lane + 256 * j; const f32x4 g = *(const f32x4*)(p.g_norm1 + c), s1 = *(const f32x4*)(scl + c); gm[j] = g * (s1 + 1.f); hm[j] = *(const f32x4*)(sh + c); }
#pragma unroll
        for (int r = 0; r < 4; ++r) { float s = 0.f;
#pragma unroll
            for (int j = 0; j < 4; ++j) s += (v[r][j].x * v[r][j].x + v[r][j].y * v[r][j].y) + (v[r][j].z * v[r][j].z + v[r][j].w * v[r][j].w);
            const float rstd = __builtin_amdgcn_rsqf(wave_sum(s) * (1.f / DM) + EPS);
            unsigned long long* o8 = (unsigned long long*)(H + (size_t)(m0 + r) * DM) + lane;
#pragma unroll
            for (int j = 0; j < 4; ++j) { const f32x4 y = v[r][j] * rstd * gm[j] + hm[j];
                o8[64 * j] = (unsigned long long)pk2h(y.x, y.y) | ((unsigned long long)pk2h(y.z, y.w) << 32); } }
    }
}

__device__ __forceinline__ void p1_extra(const Params& p, LAS unsigned char* lds, int vcu, int G, int tid, int wave, int lane) {
    unsigned char* ws = p.ws; const float* mod = (const float*)(ws + WS_MOD);
    if (vcu < 128) {
        LAS float* red = (LAS float*)lds;
        const int kl = tid >> 3, cq = tid & 7, c0 = vcu * 32 + cq * 4;
        f32x4 a0 = {0.f, 0.f, 0.f, 0.f}, a1 = {0.f, 0.f, 0.f, 0.f};
        f32x4 wv[16];
#pragma unroll
        for (int i = 0; i < 16; ++i) wv[i] = *(const f32x4*)(p.w_ff1 + (size_t)(kl + 64 * i) * DFF + c0);
#pragma unroll
        for (int i = 0; i < 16; ++i) { const int k = kl + 64 * i; a0 += wv[i] * mod[3072 + k]; a1 += wv[i] * mod[6144 + 3072 + k]; }
        *(LAS f32x4*)(red + (kl * 8 + cq) * 8) = a0; *(LAS f32x4*)(red + (kl * 8 + cq) * 8 + 4) = a1;
        __syncthreads();
        if (tid < 64) { const int cq2 = tid >> 3, j = tid & 7; float s = 0.f;
            for (int k2 = 0; k2 < 64; ++k2) s += red[(k2 * 8 + cq2) * 8 + j];
            const int b = j >> 2, col = vcu * 32 + cq2 * 4 + (j & 3);
            ((float*)(ws + WS_CB))[b * DFF + col] = s; }
        __syncthreads();
    }
}
struct EpiInProj {
    static constexpr bool PERM = true, HAS_MID = false;
    unsigned char* ws; const float* g_q; const float* g_k;
    __device__ __forceinline__ void operator()(const f32x4 (&acc)[2][2][4][2], const pg8::Unit& u, int wr, int wc, int fr, int fq) const {
        const int pn = u.pn; const int row0 = u.pm * 256 + wr * 64 + fr;
        const float* cosT = (const float*)(ws + WS_COS); const float* sinT = (const float*)(ws + WS_SIN);
        if (pn < 6 || pn == 10 || pn == 11 || (pn == 12 && wc == 0)) {
            const int kind = pn < 6 ? (pn >> 1) : (pn < 12 ? 3 : 4);
            const bool donorm = kind < 2, dorope = kind != 2, f16o = kind >= 3;
            const int head = kind < 3 ? 4 * (pn & 1) + wc : (kind == 3 ? 4 * (pn - 10) + wc : 0);
            u16* dst = (u16*)(ws + (kind == 0 ? WS_Q : kind == 1 ? WS_K : kind == 2 ? WS_V : kind == 3 ? WS_IQ : WS_IK));
            const int ld = kind == 4 ? 64 : 512;
            const float* gg = kind == 0 ? g_q : g_k;
            float gv[2][8];
#pragma unroll
            for (int bj = 0; bj < 2; ++bj)
#pragma unroll
                for (int e = 0; e < 8; ++e) gv[bj][e] = donorm ? gg[32 * bj + 8 * fq + e] * (kind == 0 ? QSCALE : 1.f) : 1.f;
#pragma unroll
            for (int ai = 0; ai < 2; ++ai)
#pragma unroll
                for (int m = 0; m < 4; ++m) {
                    const int row = row0 + ai * 128 + m * 16; const int pos = row & (SEQ - 1);
                    float v[2][8];
#pragma unroll
                    for (int bj = 0; bj < 2; ++bj)
#pragma unroll
                        for (int n = 0; n < 2; ++n)
#pragma unroll
                            for (int e = 0; e < 4; ++e) v[bj][4 * n + e] = acc[ai][bj][m][n][e];
                    float rstd = 1.f;
                    if (donorm) { float ss = 0.f;
#pragma unroll
                        for (int bj = 0; bj < 2; ++bj)
#pragma unroll
                            for (int e = 0; e < 8; ++e) ss += v[bj][e] * v[bj][e];
                        ss += __builtin_bit_cast(float, __builtin_amdgcn_ds_swizzle(__builtin_bit_cast(int, ss), 0x401F)); ss += __shfl_xor(ss, 32);
                        rstd = __builtin_amdgcn_rsqf(ss * (1.f / 64.f) + EPS); }
#pragma unroll
                    for (int bj = 0; bj < 2; ++bj)
#pragma unroll
                        for (int e = 0; e < 8; ++e) v[bj][e] = v[bj][e] * rstd * gv[bj][e];
                    if (dorope) {
                        const f32x4 c0 = *(const f32x4*)(cosT + pos * 8), c1 = *(const f32x4*)(cosT + pos * 8 + 4), s0 = *(const f32x4*)(sinT + pos * 8), s1 = *(const f32x4*)(sinT + pos * 8 + 4);
#pragma unroll
                        for (int e = 0; e < 8; ++e) { const float pv = __builtin_bit_cast(float, __builtin_amdgcn_ds_swizzle(__builtin_bit_cast(int, v[0][e]), 0x401F)); const float cc = e < 4 ? c0[e & 3] : c1[e & 3], sn = e < 4 ? s0[e & 3] : s1[e & 3];
                            const float r1 = v[0][e] * cc - pv * sn, r2 = v[0][e] * cc + pv * sn; v[0][e] = fq == 0 ? r1 : (fq == 1 ? r2 : v[0][e]); }
                    }
#pragma unroll
                    for (int bj = 0; bj < 2; ++bj) { u32x4 w;
                        if (f16o) { w.x = pk2h(v[bj][0], v[bj][1]); w.y = pk2h(v[bj][2], v[bj][3]); w.z = pk2h(v[bj][4], v[bj][5]); w.w = pk2h(v[bj][6], v[bj][7]); }
                        else { w.x = pk2bf(v[bj][0], v[bj][1]); w.y = pk2bf(v[bj][2], v[bj][3]); w.z = pk2bf(v[bj][4], v[bj][5]); w.w = pk2bf(v[bj][6], v[bj][7]); }
                        *(u32x4*)(dst + (size_t)row * ld + head * 64 + 32 * bj + 8 * fq) = w; }
                }
        } else if (pn < 10) {
            u16* dst = (u16*)(ws + WS_GLU);
#pragma unroll
            for (int ai = 0; ai < 2; ++ai)
#pragma unroll
                for (int m = 0; m < 4; ++m) { const int row = row0 + ai * 128 + m * 16; float o[8];
#pragma unroll
                    for (int n = 0; n < 2; ++n)
#pragma unroll
                        for (int e = 0; e < 4; ++e) { const float a = acc[ai][0][m][n][e], g = acc[ai][1][m][n][e]; o[4 * n + e] = a * __builtin_amdgcn_rcpf(1.f + __expf(-g)); }
                    u32x4 w; w.x = pk2bf(o[0], o[1]); w.y = pk2bf(o[2], o[3]); w.z = pk2bf(o[4], o[5]); w.w = pk2bf(o[6], o[7]);
                    *(u32x4*)(dst + (size_t)row * CW + 128 * (pn - 6) + 32 * wc + 8 * fq) = w; }
        } else if (pn == 12 && wc == 1) {
            if (fq == 0) { float* dst = (float*)(ws + WS_IW);
#pragma unroll
                for (int ai = 0; ai < 2; ++ai)
#pragma unroll
                    for (int m = 0; m < 4; ++m) { const int row = row0 + ai * 128 + m * 16;
                        *(f32x4*)(dst + (size_t)row * 8) = acc[ai][0][m][0] * IWSCALE; *(f32x4*)(dst + (size_t)row * 8 + 4) = acc[ai][0][m][1] * IWSCALE; } }
        }
    }
};
struct EpiResid {
    static constexpr bool PERM = false, HAS_MID = false;
    const float* base; float* out; const float* mod; int gate_off;
    __device__ __forceinline__ void operator()(const f32x4 (&acc)[2][2][4][2], const pg8::Unit& u, int wr, int wc, int fr, int fq) const {
        const int row0 = u.pm * 256 + wr * 64 + fr, col0 = u.pn * 256 + wc * 32 + 4 * fq; const int b = (u.pm * 256) / SEQ;
        const float* gt = mod + b * 6144 + gate_off;
#pragma unroll
        for (int bj = 0; bj < 2; ++bj)
#pragma unroll
            for (int n = 0; n < 2; ++n) { const int col = col0 + bj * 128 + n * 16; const f32x4 g = *(const f32x4*)(gt + col);
#pragma unroll
                for (int ai = 0; ai < 2; ++ai)
#pragma unroll
                    for (int m = 0; m < 4; ++m) { const size_t off = (size_t)(row0 + ai * 128 + m * 16) * DM + col;
                        const f32x4 bs = *(const f32x4*)(base + off); *(f32x4*)(out + off) = bs + g * acc[ai][bj][m][n]; } }
    }
};
struct EpiFinal {
    static constexpr bool PERM = true, HAS_MID = false;
    const u16* x1b; float* out; const float* mod;
    __device__ __forceinline__ void operator()(const f32x4 (&acc)[2][2][4][2], const pg8::Unit& u, int wr, int wc, int fr, int fq) const {
        const int row0 = u.pm * 256 + wr * 64 + fr, col0 = u.pn * 256 + wc * 32 + 8 * fq; const int b = (u.pm * 256) / SEQ;
        const float* gt = mod + b * 6144 + 5120;
#pragma unroll
        for (int bj = 0; bj < 2; ++bj) { const int col = col0 + bj * 128; const f32x4 g0 = *(const f32x4*)(gt + col), g1 = *(const f32x4*)(gt + col + 4);
#pragma unroll
            for (int ai = 0; ai < 2; ++ai)
#pragma unroll
                for (int m = 0; m < 4; ++m) { const size_t off = (size_t)(row0 + ai * 128 + m * 16) * DM + col;
                    const u32x4 w = *(const u32x4*)(x1b + off);
                    f32x4 bs0, bs1;
                    bs0.x = bf2f((u16)(w.x & 0xffff)); bs0.y = bf2f((u16)(w.x >> 16)); bs0.z = bf2f((u16)(w.y & 0xffff)); bs0.w = bf2f((u16)(w.y >> 16));
                    bs1.x = bf2f((u16)(w.z & 0xffff)); bs1.y = bf2f((u16)(w.z >> 16)); bs1.z = bf2f((u16)(w.w & 0xffff)); bs1.w = bf2f((u16)(w.w >> 16));
                    *(f32x4*)(out + off) = bs0 + g0 * acc[ai][bj][m][0]; *(f32x4*)(out + off + 4) = bs1 + g1 * acc[ai][bj][m][1]; } }
    }
};
struct EpiOut {
    static constexpr bool PERM = true, HAS_MID = true;
    const float* base; u16* x1b; float* ss2; const float* mod; const float* ssp;
    __device__ __forceinline__ void pre(float (&rs)[2][4], const pg8::Unit& u, int wr, int fr) const {
        const int row0 = u.pm * 256 + wr * 64 + fr;
#pragma unroll
        for (int ai = 0; ai < 2; ++ai)
#pragma unroll
            for (int m = 0; m < 4; ++m) { const float* sp = ssp + (size_t)(row0 + ai * 128 + m * 16) * 8; const f32x4 s0 = *(const f32x4*)sp, s1 = *(const f32x4*)(sp + 4);
                const float ss = ((s0.x + s0.y) + (s0.z + s0.w)) + ((s1.x + s1.y) + (s1.z + s1.w)); rs[ai][m] = __builtin_amdgcn_rsqf(ss * (1.f / AW) + EPS); }
    }
    __device__ __forceinline__ void mid(f32x4 (&acc)[2][2][4][2], const float (&rs)[2][4]) const {
#pragma unroll
        for (int ai = 0; ai < 2; ++ai)
#pragma unroll
            for (int m = 0; m < 4; ++m)
#pragma unroll
                for (int bj = 0; bj < 2; ++bj)
#pragma unroll
                    for (int n = 0; n < 2; ++n) acc[ai][bj][m][n] *= rs[ai][m];
    }
    __device__ __forceinline__ void operator()(const f32x4 (&acc)[2][2][4][2], const pg8::Unit& u, int wr, int wc, int fr, int fq) const {
        const int row0 = u.pm * 256 + wr * 64 + fr, col0 = u.pn * 256 + wc * 32 + 8 * fq; const int b = (u.pm * 256) / SEQ;
        const float* gt = mod + b * 6144 + 2048;
        float rsq[2][4];
#pragma unroll
        for (int ai = 0; ai < 2; ++ai)
#pragma unroll
            for (int m = 0; m < 4; ++m) rsq[ai][m] = 0.f;
#pragma unroll
        for (int bj = 0; bj < 2; ++bj) { const int col = col0 + bj * 128; const f32x4 g0 = *(const f32x4*)(gt + col), g1 = *(const f32x4*)(gt + col + 4);
#pragma unroll
            for (int ai = 0; ai < 2; ++ai)
#pragma unroll
                for (int m = 0; m < 4; ++m) { const size_t off = (size_t)(row0 + ai * 128 + m * 16) * DM + col;
                    const f32x4 xa = *(const f32x4*)(base + off) + g0 * acc[ai][bj][m][0], xb = *(const f32x4*)(base + off + 4) + g1 * acc[ai][bj][m][1];
                    u32x4 w; w.x = pk2bf(xa.x, xa.y); w.y = pk2bf(xa.z, xa.w); w.z = pk2bf(xb.x, xb.y); w.w = pk2bf(xb.z, xb.w);
                    *(u32x4*)(x1b + off) = w;
                    rsq[ai][m] += ((xa.x * xa.x + xa.y * xa.y) + (xa.z * xa.z + xa.w * xa.w)) + ((xb.x * xb.x + xb.y * xb.y) + (xb.z * xb.z + xb.w * xb.w)); } }
#pragma unroll
        for (int ai = 0; ai < 2; ++ai)
#pragma unroll
            for (int m = 0; m < 4; ++m) { float v = rsq[ai][m]; v += __shfl_xor(v, 16); v += __shfl_xor(v, 32); if (fq == 0) atomicAdd(ss2 + row0 + ai * 128 + m * 16, v); }
    }
};
struct EpiFF1 {
    static constexpr bool PERM = true, HAS_MID = false;
    u16* O; const float* ss2; const float* cb;
    __device__ __forceinline__ void operator()(const f32x4 (&acc)[2][2][4][2], const pg8::Unit& u, int wr, int wc, int fr, int fq) const {
        const int row0 = u.pm * 256 + wr * 64 + fr, col0 = u.pn * 256 + wc * 32 + 8 * fq; const int b = (u.pm * 256) / SEQ;
        f32x4 c0[2], c1[2];
#pragma unroll
        for (int bj = 0; bj < 2; ++bj) { c0[bj] = *(const f32x4*)(cb + b * DFF + col0 + bj * 128); c1[bj] = *(const f32x4*)(cb + b * DFF + col0 + bj * 128 + 4); }
#pragma unroll
        for (int ai = 0; ai < 2; ++ai)
#pragma unroll
            for (int m = 0; m < 4; ++m) { const int row = row0 + ai * 128 + m * 16; const float rs = __builtin_amdgcn_rsqf(ss2[row] * (1.f / DM) + EPS);
                u16* rowp = O + (size_t)row * DFF + col0;
#pragma unroll
                for (int bj = 0; bj < 2; ++bj) { f32x4 a = acc[ai][bj][m][0] * rs + c0[bj], c = acc[ai][bj][m][1] * rs + c1[bj];
#pragma unroll
                    for (int e = 0; e < 4; ++e) { const float x0 = fmaxf(a[e], 0.f), x1 = fmaxf(c[e], 0.f); a[e] = x0 * x0; c[e] = x1 * x1; }
                    u32x4 w; w.x = pk2bf(a[0], a[1]); w.y = pk2bf(a[2], a[3]); w.z = pk2bf(c[0], c[1]); w.w = pk2bf(c[2], c[3]);
                    *(u32x4*)(rowp + bj * 128) = w; } }
    }
};

constexpr int IX_CAP = 576;
constexpr int IX_IK = 0, IX_MASK = 0, IX_HIST = 32768, IX_CS = 32768, IX_CI = IX_CS + 32 * IX_CAP * 4, IX_INFO = IX_CI + 32 * IX_CAP * 2;
__device__ __forceinline__ int score_bin(float s) {
    const unsigned bits = __builtin_bit_cast(unsigned, s);
    const int mb = (int)((bits >> 18) & 0x1fffu);
    int c = mb - 3775; c = c < 0 ? 0 : (c > 511 ? 511 : c);
    const int sg = (int)bits >> 31;
    return (c ^ sg) + 512;
}
__device__ __forceinline__ int score_key(float s) { const int b = __builtin_bit_cast(int, s); return b ^ ((b >> 31) & 0x7fffffff); }
__device__ __forceinline__ int bin_keylo(int b) {
    if (b > 1023) return 0x7fffffff;
    if (b >= 512) { const int c = b - 512; return c == 0 ? 0 : ((c + 3775) << 18); }
    const int c = 511 - b; return c == 511 ? (int)0x80000000 : -((c + 3776) << 18);
}
__device__ __forceinline__ f32x16 idx_mma(const h16x8 (&af)[4], const h16x8 (&bf)[4]) {
    f32x16 c = {0.f, 0.f, 0.f, 0.f, 0.f, 0.f, 0.f, 0.f, 0.f, 0.f, 0.f, 0.f, 0.f, 0.f, 0.f, 0.f};
#pragma unroll
    for (int ks = 0; ks < 4; ++ks) c = __builtin_amdgcn_mfma_f32_32x32x16_f16(af[ks], bf[ks], c, 0, 0, 0);
    return c;
}
__device__ __forceinline__ void idx_epi(const f32x16& c, const float (&wq)[2][8], float& sA, float& sB) {
    float a = 0.f, b = 0.f;
#pragma unroll
    for (int j = 0; j < 8; ++j) { const float xa = __builtin_amdgcn_fmed3f(c[j] * 0x1p-12f, 0.f, 1.f), xb = __builtin_amdgcn_fmed3f(c[8 + j] * 0x1p-12f, 0.f, 1.f);
        asm("v_fmac_f32 %0, %1, %2" : "+v"(a) : "v"(xa), "v"(wq[0][j]));
        asm("v_fmac_f32 %0, %1, %2" : "+v"(b) : "v"(xb), "v"(wq[1][j])); }
    sA = a; sB = b;
}
typedef _Float16 h16x2 __attribute__((ext_vector_type(2)));
__device__ __forceinline__ int count_ge9(const unsigned (&u)[9], unsigned mid) {
    unsigned long long m0, m1, m2, m3, m4, m5, m6, m7, m8;
    asm("v_cmp_le_u32_e64 %0, %9, %10\n\tv_cmp_le_u32_e64 %1, %9, %11\n\tv_cmp_le_u32_e64 %2, %9, %12\n\tv_cmp_le_u32_e64 %3, %9, %13\n\t"
        "v_cmp_le_u32_e64 %4, %9, %14\n\tv_cmp_le_u32_e64 %5, %9, %15\n\tv_cmp_le_u32_e64 %6, %9, %16\n\tv_cmp_le_u32_e64 %7, %9, %17\n\tv_cmp_le_u32_e64 %8, %9, %18"
        : "=&s"(m0), "=&s"(m1), "=&s"(m2), "=&s"(m3), "=&s"(m4), "=&s"(m5), "=&s"(m6), "=&s"(m7), "=&s"(m8)
        : "s"(mid), "v"(u[0]), "v"(u[1]), "v"(u[2]), "v"(u[3]), "v"(u[4]), "v"(u[5]), "v"(u[6]), "v"(u[7]), "v"(u[8]));
    return __popcll(m0) + __popcll(m1) + __popcll(m2) + __popcll(m3) + __popcll(m4) + __popcll(m5) + __popcll(m6) + __popcll(m7) + __popcll(m8);
}
template <int VAR> __device__ __forceinline__ void idx_unit(const Params& p, LAS unsigned char* lds, int b, int hc, int tid, int wave, int lane) {
    const int t0 = hc * 32, N = 64 * (t0 / 64 + 1), NBT = (N + 127) >> 7, NST = N >> 5;
    const size_t rowb = (size_t)b * SEQ;
    unsigned* gmask = (unsigned*)(p.ws + (VAR ? WS_H : WS_MASK)) + (rowb + t0) * 256;
    LAS unsigned* lmask = (LAS unsigned*)(lds + IX_MASK);
    if (N <= 256) {
        for (int e = tid; e < 32 * 256; e += NTHR) { const int w = e & 255; gmask[e] = (w * 32 < N) ? 0xffffffffu : 0u; }
        return;
    }
    const u16* IQ = (const u16*)(p.ws + WS_IQ); const u16* IK = (const u16*)(p.ws + WS_IK); const float* IW = (const float*)(p.ws + WS_IW);
    const int qg = wave & 3, kh = wave >> 2, half = lane >> 5;
    h16x8 af[2][4]; float wq[2][2][8];
    { const int r = lane & 31, q = 2 * (r >> 4) + ((r >> 2) & 1), hd = (r & 3) + 4 * ((r >> 3) & 1);
#pragma unroll
      for (int a = 0; a < 2; ++a) { const u16* src = IQ + (rowb + t0 + 8 * qg + 4 * a + q) * 512 + hd * 64 + 8 * half;
#pragma unroll
          for (int ks = 0; ks < 4; ++ks) af[a][ks] = *(const h16x8*)(src + 16 * ks);
#pragma unroll
          for (int s2 = 0; s2 < 2; ++s2) { const float* wp = IW + (rowb + t0 + 8 * qg + 4 * a + 2 * s2 + half) * 8; const f32x4 w0 = *(const f32x4*)wp, w1 = *(const f32x4*)(wp + 4);
              wq[a][s2][0] = w0.x * 4096.f; wq[a][s2][1] = w0.y * 4096.f; wq[a][s2][2] = w0.z * 4096.f; wq[a][s2][3] = w0.w * 4096.f; wq[a][s2][4] = w1.x * 4096.f; wq[a][s2][5] = w1.y * 4096.f; wq[a][s2][6] = w1.z * 4096.f; wq[a][s2][7] = w1.w * 4096.f; } } }
    for (int e = tid; e < 65536 / 16; e += NTHR) *(LAS u32x4*)(lds + IX_HIST + e * 16) = (u32x4){0u, 0u, 0u, 0u};
    LAS int* info = (LAS int*)(lds + IX_INFO);
    int rowA[2], rowB[2];
#pragma unroll
    for (int a = 0; a < 2; ++a) { rowA[a] = 8 * qg + 4 * a + half; rowB[a] = rowA[a] + 2; }
    const int skey = tid >> 3, schunk = tid & 7; const int sdst = skey * 128 + ((schunk ^ ((skey >> 1) & 7)) * 16);
    const u16* ikg = IK + rowb * 64 + schunk * 8;
#define IDX_BFRAGS(ikt) h16x8 bf[2][4]; \
        _Pragma("unroll") for (int i = 0; i < 2; ++i) { const int key = (kh + 2 * i) * 32 + (lane & 31); \
            _Pragma("unroll") for (int ks = 0; ks < 4; ++ks) bf[i][ks] = *(const LAS h16x8*)((ikt) + key * 128 + (((2 * ks + half) ^ ((key >> 1) & 7)) * 16)); }
    {
        const int NBS = (NBT + 3) >> 2;
        auto sload = [&](int bs, u32x4& s0, u32x4& s1) __attribute__((always_inline)) {
            int j0 = 4 * bs + (skey >> 5), j1 = j0 + 2; j0 = j0 < NBT ? j0 : NBT - 1; j1 = j1 < NBT ? j1 : NBT - 1;
            s0 = *(const u32x4*)(ikg + (size_t)(128 * j0 + (skey & 31)) * 64); s1 = *(const u32x4*)(ikg + (size_t)(128 * j1 + (skey & 31)) * 64); };
        u32x4 stg0, stg1; sload(0, stg0, stg1);
        *(LAS u32x4*)(lds + IX_IK + sdst) = stg0; *(LAS u32x4*)(lds + IX_IK + 8192 + sdst) = stg1;
        __syncthreads();
        for (int bs = 0; bs < NBS; ++bs) {
            const LAS unsigned char* ikt = lds + IX_IK + (bs & 1) * 16384;
            sload(bs + 1 < NBS ? bs + 1 : bs, stg0, stg1);
            IDX_BFRAGS(ikt)
#define IDX_HIST(ACC, i, a) do { float sA, sB; idx_epi(ACC, wq[a], sA, sB); const unsigned one = (4 * bs + kh + 2 * (i)) < NBT ? 1u : 0u; \
                const int bA = score_bin(sA), bB = score_bin(sB); \
                lds_add_u32((LAS unsigned*)(lds + IX_HIST + rowA[a] * 2048 + (bA >> 1) * 4), one << ((bA & 1) * 16)); \
                lds_add_u32((LAS unsigned*)(lds + IX_HIST + rowB[a] * 2048 + (bB >> 1) * 4), one << ((bB & 1) * 16)); } while (0)
            f32x16 acc0 = idx_mma(af[0], bf[0]);
            f32x16 acc1 = idx_mma(af[1], bf[0]);
            IDX_HIST(acc0, 0, 0);
            acc0 = idx_mma(af[0], bf[1]);
            IDX_HIST(acc1, 0, 1);
            acc1 = idx_mma(af[1], bf[1]);
            IDX_HIST(acc0, 1, 0);
            IDX_HIST(acc1, 1, 1);
#undef IDX_HIST
            *(LAS u32x4*)(lds + IX_IK + ((bs + 1) & 1) * 16384 + sdst) = stg0; *(LAS u32x4*)(lds + IX_IK + ((bs + 1) & 1) * 16384 + 8192 + sdst) = stg1;
            __syncthreads();
        }
        const float nf = 32.f * (float)NBT, pf = 256.f / (float)N; const float varf = nf * pf * (1.f - pf) * (1.f - nf / (float)N);
        const unsigned R = (unsigned)(int)(nf * pf + 4.5f * sqrtf(varf > 0.f ? varf : 0.f) + 2.f);
        int tlo[4];
        for (int rr = 0; rr < 4; ++rr) { const int row = 4 * wave + rr;
            const LAS unsigned* hrow = (const LAS unsigned*)(lds + IX_HIST + row * 2048) + lane * 8;
            unsigned cnt[16]; unsigned tot = 0;
#pragma unroll
            for (int j = 0; j < 8; ++j) { const unsigned w = hrow[j]; cnt[2 * j] = w & 0xffffu; cnt[2 * j + 1] = w >> 16; tot += cnt[2 * j] + cnt[2 * j + 1]; }
            unsigned incl = tot;
            incl += (unsigned)__builtin_amdgcn_update_dpp(0, (int)incl, 0x101, 0xF, 0xF, true);
            incl += (unsigned)__builtin_amdgcn_update_dpp(0, (int)incl, 0x102, 0xF, 0xF, true);
            incl += (unsigned)__builtin_amdgcn_update_dpp(0, (int)incl, 0x104, 0xF, 0xF, true);
            incl += (unsigned)__builtin_amdgcn_update_dpp(0, (int)incl, 0x108, 0xF, 0xF, true);
            { const unsigned t1 = (unsigned)__builtin_amdgcn_readlane((int)incl, 16), t2 = (unsigned)__builtin_amdgcn_readlane((int)incl, 32), t3 = (unsigned)__builtin_amdgcn_readlane((int)incl, 48);
              incl += lane < 16 ? t1 + t2 + t3 : (lane < 32 ? t2 + t3 : (lane < 48 ? t3 : 0u)); }
            const unsigned above = incl - tot;
            int fs = -1;
            if (above < R && above + tot >= R) { unsigned run = above;
#pragma unroll
                for (int j = 15; j >= 0; --j) { const unsigned cjj = cnt[j]; if (run < R && run + cjj >= R) fs = 16 * lane + j; run += cjj; } }
            const unsigned long long fm = __ballot(fs >= 0); const int src = fm ? (int)__builtin_ctzll(fm) : 0;
            const int fsb = __builtin_amdgcn_readlane(fs, src);
            tlo[rr] = fm ? bin_keylo(fsb) : (int)0x80000000;
        }
        __syncthreads();
        if (lane == 0) { for (int rr = 0; rr < 4; ++rr) { const int k = tlo[rr]; info[(4 * wave + rr) * 4 + 2] = 1; info[128 + (4 * wave + rr) * 2] = (int)0x80000000; info[128 + (4 * wave + rr) * 2 + 1] = 0x7fffffff; info[(4 * wave + rr) * 4] = (k == (int)0x80000000) ? (int)0xff800000 : (k ^ ((k >> 31) & 0x7fffffff)); } }
        __syncthreads();
    }
    for (int attempt = 0; ; ++attempt) {
        float tA[2], tB[2]; LAS unsigned char *ctrA[2], *ctrB[2], *csA[2], *csB[2], *ciA[2], *ciB[2];
#pragma unroll
        for (int a = 0; a < 2; ++a) { tA[a] = info[rowA[a] * 4 + 2] ? __builtin_bit_cast(float, info[rowA[a] * 4]) : __builtin_inff(); tB[a] = info[rowB[a] * 4 + 2] ? __builtin_bit_cast(float, info[rowB[a] * 4]) : __builtin_inff();
            ctrA[a] = lds + IX_INFO + rowA[a] * 16 + 4; ctrB[a] = lds + IX_INFO + rowB[a] * 16 + 4;
            csA[a] = lds + IX_CS + rowA[a] * (IX_CAP * 4); csB[a] = lds + IX_CS + rowB[a] * (IX_CAP * 4); ciA[a] = lds + IX_CI + rowA[a] * (IX_CAP * 2); ciB[a] = lds + IX_CI + rowB[a] * (IX_CAP * 2); }
        LAS unsigned char* dummy = lds + IX_INFO + 1024 + tid * 4;
        float dsum = 0.f;
        if (tid < 32 && info[tid * 4 + 2]) info[tid * 4 + 1] = 0;
        if (tid == 32) info[3] = 0;
        u32x4 stg0 = *(const u32x4*)(ikg + (size_t)skey * 64), stg1 = *(const u32x4*)(ikg + (size_t)(skey + 64) * 64);
        *(LAS u32x4*)(lds + IX_IK + sdst) = stg0; *(LAS u32x4*)(lds + IX_IK + 8192 + sdst) = stg1;
        { const int nb = 1 < NBT ? 1 : 0; stg0 = *(const u32x4*)(ikg + (size_t)(nb * 128 + skey) * 64); stg1 = *(const u32x4*)(ikg + (size_t)(nb * 128 + skey + 64) * 64); }
        __syncthreads();
        h16x8 bfA[2][4], bfB[2][4];
#define IDX_RDFRAGS(BF, ikt) do { _Pragma("unroll") for (int i = 0; i < 2; ++i) { const int key = (kh + 2 * i) * 32 + (lane & 31); \
            _Pragma("unroll") for (int ks = 0; ks < 4; ++ks) BF[i][ks] = *(const LAS h16x8*)((ikt) + key * 128 + (((2 * ks + half) ^ ((key >> 1) & 7)) * 16)); } } while (0)
        IDX_RDFRAGS(bfA, lds + IX_IK);
#define IDX_REQ(ACC, i, a, KA, KB, PA, PB, SLA, SLB, KI) do { float sA, sB; if (VAR == 7) { sA = ACC[0]; sB = ACC[8]; } else idx_epi(ACC, wq[a], sA, sB); \
                if (VAR == 6 || VAR == 7) { dsum += sA + sB; PA = false; PB = false; KA = 0; KB = 0; SLA = 0; SLB = 0; KI = 0; break; } \
                const int st_ = 4 * bt + kh + 2 * (i); const bool valid_ = st_ < NST; KI = 32 * st_ + (lane & 31); \
                KA = __builtin_bit_cast(int, sA); KB = __builtin_bit_cast(int, sB); PA = (sA >= tA[a]) && valid_; PB = (sB >= tB[a]) && valid_; \
                SLA = lds_add_u32((LAS unsigned*)(PA ? ctrA[a] : dummy), 1u); SLB = lds_add_u32((LAS unsigned*)(PB ? ctrB[a] : dummy), 1u); } while (0)
#define IDX_PUT(a, KA, KB, PA, PB, SLA, SLB, KI) do {   \
                { const bool ok_ = PA && SLA < (unsigned)IX_CAP; LAS unsigned char* a1_ = ok_ ? csA[a] + SLA * 4 : dummy; LAS unsigned char* a2_ = ok_ ? ciA[a] + SLA * 2 : dummy; \
                  *(LAS int*)a1_ = KA; *(LAS u16*)a2_ = (u16)(KI); } \
                { const bool ok_ = PB && SLB < (unsigned)IX_CAP; LAS unsigned char* a1_ = ok_ ? csB[a] + SLB * 4 : dummy; LAS unsigned char* a2_ = ok_ ? ciB[a] + SLB * 2 : dummy; \
                  *(LAS int*)a1_ = KB; *(LAS u16*)a2_ = (u16)(KI); } } while (0)
        int kA0 = 0, kB0 = 0, kA1 = 0, kB1 = 0, kA2 = 0, kB2 = 0, kA3 = 0, kB3 = 0, ki0 = 0, ki1 = 0, ki2 = 0, ki3 = 0;
        bool pA0 = false, pB0 = false, pA1 = false, pB1 = false, pA2 = false, pB2 = false, pA3 = false, pB3 = false;
        unsigned slA0 = 0, slB0 = 0, slA1 = 0, slB1 = 0, slA2 = 0, slB2 = 0, slA3 = 0, slB3 = 0;
#define IDX_FSTEP(BF, BN) do { \
            *(LAS u32x4*)(lds + IX_IK + ((bt + 1) & 1) * 16384 + sdst) = stg0; *(LAS u32x4*)(lds + IX_IK + ((bt + 1) & 1) * 16384 + 8192 + sdst) = stg1; \
            { const int nb = bt + 2 < NBT ? bt + 2 : NBT - 1; stg0 = *(const u32x4*)(ikg + (size_t)(nb * 128 + skey) * 64); stg1 = *(const u32x4*)(ikg + (size_t)(nb * 128 + skey + 64) * 64); } \
            __syncthreads(); \
            IDX_RDFRAGS(BN, lds + IX_IK + ((bt + 1) & 1) * 16384); \
            f32x16 acc0 = idx_mma(af[0], BF[0]); \
            f32x16 acc1 = idx_mma(af[1], BF[0]); \
            IDX_PUT(0, kA2, kB2, pA2, pB2, slA2, slB2, ki2);              \
            IDX_REQ(acc0, 0, 0, kA0, kB0, pA0, pB0, slA0, slB0, ki0); \
            acc0 = idx_mma(af[0], BF[1]); \
            IDX_PUT(1, kA3, kB3, pA3, pB3, slA3, slB3, ki3);              \
            IDX_REQ(acc1, 0, 1, kA1, kB1, pA1, pB1, slA1, slB1, ki1); \
            IDX_PUT(0, kA0, kB0, pA0, pB0, slA0, slB0, ki0); \
            acc1 = idx_mma(af[1], BF[1]); \
            IDX_REQ(acc0, 1, 0, kA2, kB2, pA2, pB2, slA2, slB2, ki2); \
            IDX_PUT(1, kA1, kB1, pA1, pB1, slA1, slB1, ki1); \
            IDX_REQ(acc1, 1, 1, kA3, kB3, pA3, pB3, slA3, slB3, ki3); } while (0)
        int bt = 0;
        for (; bt + 1 < NBT; bt += 2) { IDX_FSTEP(bfA, bfB); ++bt; IDX_FSTEP(bfB, bfA); --bt; }
        if (bt < NBT) { IDX_FSTEP(bfA, bfB); }
        __syncthreads();
#undef IDX_FSTEP
#undef IDX_RDFRAGS
        IDX_PUT(0, kA2, kB2, pA2, pB2, slA2, slB2, ki2);
        IDX_PUT(1, kA3, kB3, pA3, pB3, slA3, slB3, ki3);
        if (VAR == 6 || VAR == 7) *(LAS float*)dummy = dsum;
#undef IDX_REQ
#undef IDX_PUT
        __syncthreads();
        if (tid < 32 && info[tid * 4 + 2]) {
            const int c = info[tid * 4 + 1]; int redo = 0;
            if ((c < 256 || c > IX_CAP) && attempt < 48) {
                const int fb = info[tid * 4]; int k = score_key(__builtin_bit_cast(float, fb));
                int klo = info[128 + tid * 2], khi = info[128 + tid * 2 + 1];
                if (c < 256) khi = k; else klo = k;
                const long long step = (long long)1 << (18 + 2 * attempt < 31 ? 18 + 2 * attempt : 31);
                long long kn = (c < 256) ? (klo != (int)0x80000000 ? ((long long)klo + khi) / 2 : (long long)k - step)
                                         : (khi != 0x7fffffff ? ((long long)klo + khi) / 2 : (long long)k + step / 8);
                kn = kn < -2147483647LL ? -2147483647LL : (kn > 2147483646LL ? 2147483646LL : kn);
                const int kk = (int)kn;
                info[128 + tid * 2] = klo; info[128 + tid * 2 + 1] = khi;
                info[tid * 4] = (kk <= -2139095041) ? (int)0xff800000 : (kk ^ ((kk >> 31) & 0x7fffffff));
                redo = 1; info[3] = 1; }
            info[tid * 4 + 2] = redo; }
        __syncthreads();
        const bool again = info[3] != 0;
        __syncthreads();
        if (!again) break;
    }
#undef IDX_BFRAGS
    for (int e = tid; e < 32768 / 16; e += NTHR) *(LAS u32x4*)(lds + IX_MASK + e * 16) = (u32x4){0u, 0u, 0u, 0u};
    __syncthreads();
    if (VAR == 2) { for (int e = tid; e < 32 * 256 / 4; e += NTHR) ((u32x4*)(p.ws + WS_H + 8 * MiB) + (size_t)(b * 256 + hc) * 2048)[e] = *(const LAS u32x4*)(lds + IX_CS + e * 16); __syncthreads(); return; }
    {
        unsigned uk[4][9]; int kx[4][9]; int Cn[4];
#pragma unroll
        for (int rr = 0; rr < 4; ++rr) { const int row = 4 * wave + rr;
            int c0 = info[row * 4 + 1];
#ifdef DEBUG_CHECK
            if (VAR == 0 && lane == 0 && c0 > IX_CAP) atomicAdd((unsigned*)(p.ws + WS_CTL) + 14, 1u);
#endif
            c0 = c0 > IX_CAP ? IX_CAP : c0;
            Cn[rr] = c0;
            const LAS int* cs = (const LAS int*)(lds + IX_CS) + row * IX_CAP; const LAS u16* ci = (const LAS u16*)(lds + IX_CI) + row * IX_CAP;
#pragma unroll
            for (int e = 0; e < 9; ++e) { const int pi = lane + 64 * e; const bool ok = pi < c0;
                const unsigned u = (unsigned)score_key(__builtin_bit_cast(float, cs[pi])) ^ 0x80000000u; uk[rr][e] = ok ? (u == 0u ? 1u : u) : 0u; kx[rr][e] = ok ? (int)ci[pi] : 0x7fffffff; } }
        unsigned lo[4], hi[4], p0[4];
#pragma unroll
        for (int rr = 0; rr < 4; ++rr) { lo[rr] = 1u; hi[rr] = Cn[rr] <= 256 ? 2u : 0xffffffffu;
            const int tb = __builtin_amdgcn_readfirstlane(info[(4 * wave + rr) * 4]);
            p0[rr] = (unsigned)score_key(__builtin_bit_cast(float, tb)) ^ 0x80000000u; }
#define IDX_BIS(MIDEXPR, CHECK) do { \
            _Pragma("unroll") for (int rr = 0; rr < 4; ++rr) { if (!(CHECK) && hi[rr] - lo[rr] <= 1u) continue;       \
                const unsigned mid = (MIDEXPR); \
                const int cnt = count_ge9(uk[rr], mid); \
                const bool ok = !(CHECK) || (mid - lo[rr] - 1u) < (hi[rr] - lo[rr] - 1u);             \
                const unsigned nlo = cnt >= 256 ? mid : lo[rr], nhi = cnt > 256 ? hi[rr] : (cnt == 256 ? mid + 1u : mid); \
                lo[rr] = ok ? nlo : lo[rr]; hi[rr] = ok ? nhi : hi[rr]; ex[rr] = (ok && cnt == 256) ? true : ex[rr]; } } while (0)
        bool ex[4] = {false, false, false, false};
        if (VAR != 14) {
            IDX_BIS(p0[rr], true);
            IDX_BIS(lo[rr] + (1u << 22), true);
            if (p0[0] <= 0x80000000u || p0[1] <= 0x80000000u || p0[2] <= 0x80000000u || p0[3] <= 0x80000000u) {
                IDX_BIS(0x80000001u, true);
                IDX_BIS(0x80000000u, true);
            }
            for (int it = 0; it < 32; ++it) {
                IDX_BIS(lo[rr] + ((hi[rr] - lo[rr]) >> 1), false);
                const unsigned w = ((hi[0] - lo[0]) | (hi[1] - lo[1]) | (hi[2] - lo[2]) | (hi[3] - lo[3]));
                if (w <= 1u) break;
            }
        }
#undef IDX_BIS
#pragma unroll
        for (int rr = 0; rr < 4; ++rr) { const int row = 4 * wave + rr;
            unsigned thr = lo[rr]; int need = 0;
            if (ex[rr] || Cn[rr] <= 256) {
                const unsigned t2 = Cn[rr] <= 256 ? 1u : thr;
#pragma unroll
                for (int e = 0; e < 9; ++e) if (uk[rr][e] >= t2 && kx[rr][e] != 0x7fffffff) lds_or_u32((LAS unsigned*)&lmask[row * 256 + (kx[rr][e] >> 5)], 1u << (kx[rr][e] & 31));
                continue; }
            if (Cn[rr] <= 256) thr = 0u;
            else { int above = 0;
#pragma unroll
                for (int e = 0; e < 9; ++e) above += __popcll(__ballot(uk[rr][e] > thr));
                need = 256 - above; }
            bool sel[9]; int ntie = 0;
#pragma unroll
            for (int e = 0; e < 9; ++e) ntie += __popcll(__ballot(uk[rr][e] == thr && thr != 0u));
            const bool alltie = ntie <= need;
#pragma unroll
            for (int e = 0; e < 9; ++e) sel[e] = uk[rr][e] > thr || (alltie && uk[rr][e] == thr);
            if (!alltie) {
                int ilo = -1, ihi = 8191;
                for (int it = 0; it < 13; ++it) { const int imid = (ilo + ihi) >> 1; int c = 0;
#pragma unroll
                    for (int e = 0; e < 9; ++e) c += __popcll(__ballot(uk[rr][e] == thr && kx[rr][e] <= imid));
                    if (c >= need) ihi = imid; else ilo = imid; }
#pragma unroll
                for (int e = 0; e < 9; ++e) sel[e] = sel[e] || (uk[rr][e] == thr && kx[rr][e] <= ihi);
            }
#pragma unroll
            for (int e = 0; e < 9; ++e) if (sel[e] && kx[rr][e] != 0x7fffffff) lds_or_u32((LAS unsigned*)&lmask[row * 256 + (kx[rr][e] >> 5)], 1u << (kx[rr][e] & 31));
        }
    }
    __syncthreads();
    for (int e = tid; e < 32 * 256 / 4; e += NTHR) ((u32x4*)gmask)[e] = *(const LAS u32x4*)(lds + IX_MASK + e * 16);
    __syncthreads();
}

constexpr int CV_IN = 0, CV_Y = 65536;
__device__ __forceinline__ void conv_unit(const Params& p, LAS unsigned char* lds, int unit, int tid, int wave, int lane) {
    const int b = unit >> 8, t0 = (unit & 255) * 32; const size_t rowb = (size_t)b * SEQ;
    const u16* G = (const u16*)(p.ws + WS_GLU); u16* MX = (u16*)(p.ws + WS_CONV);
    LAS u16* ubuf = (LAS u16*)(lds + CV_IN); LAS float* ybuf = (LAS float*)(lds + CV_Y);
    { u32x4 sv[8];
#pragma unroll
      for (int i = 0; i < 8; ++i) { const int e = tid + i * NTHR; const int r = e >> 6, c = e & 63; const int t = t0 - 30 + r;
          sv[i] = (u32x4){0u, 0u, 0u, 0u}; if (e < 62 * 64 && t >= 0) sv[i] = *(const u32x4*)(G + (rowb + t) * CW + c * 8); }
#pragma unroll
      for (int i = 0; i < 8; ++i) { const int e = tid + i * NTHR; if (e < 62 * 64) *(LAS u32x4*)(ubuf + (e >> 6) * 512 + (e & 63) * 8) = sv[i]; } }
    __syncthreads();
    {
        const int c = tid; float w[CK];
#pragma unroll
        for (int j = 0; j < CK; ++j) w[j] = p.w_dw[j * CW + c];
        const float bias = p.b_dw[c];
        float u[62];
#pragma unroll
        for (int i = 0; i < 62; ++i) u[i] = bf2f(ubuf[i * 512 + c]);
#pragma unroll
        for (int i = 0; i < 32; ++i) { float a = bias;
#pragma unroll
            for (int j = 0; j < CK; ++j) a = fmaf(w[j], u[i + j], a);
            ybuf[i * 512 + c] = a; }
    }
    __syncthreads();
    {
        float v[4][8]; float s[4], q[4], ss[4];
        const f32x4 g0 = *(const f32x4*)(p.g_conv_ln + 8 * lane), g1 = *(const f32x4*)(p.g_conv_ln + 8 * lane + 4), b0 = *(const f32x4*)(p.b_conv_ln + 8 * lane), b1 = *(const f32x4*)(p.b_conv_ln + 8 * lane + 4);
#pragma unroll
        for (int rr = 0; rr < 4; ++rr) { const int tok = 4 * wave + rr;
            const f32x4 a = *(const LAS f32x4*)(ybuf + tok * 512 + 8 * lane), c2 = *(const LAS f32x4*)(ybuf + tok * 512 + 8 * lane + 4);
            v[rr][0] = a.x; v[rr][1] = a.y; v[rr][2] = a.z; v[rr][3] = a.w; v[rr][4] = c2.x; v[rr][5] = c2.y; v[rr][6] = c2.z; v[rr][7] = c2.w;
            s[rr] = 0.f;
#pragma unroll
            for (int e = 0; e < 8; ++e) s[rr] += v[rr][e]; }
#pragma unroll
        for (int rr = 0; rr < 4; ++rr) s[rr] = wave_sum(s[rr]);
#pragma unroll
        for (int rr = 0; rr < 4; ++rr) { const float mu = s[rr] * (1.f / CW); q[rr] = 0.f;
#pragma unroll
            for (int e = 0; e < 8; ++e) { v[rr][e] -= mu; q[rr] += v[rr][e] * v[rr][e]; } }
#pragma unroll
        for (int rr = 0; rr < 4; ++rr) q[rr] = wave_sum(q[rr]);
#pragma unroll
        for (int rr = 0; rr < 4; ++rr) { const float rstd = __builtin_amdgcn_rsqf(q[rr] * (1.f / CW) + EPS); ss[rr] = 0.f;
#pragma unroll
            for (int e = 0; e < 8; ++e) { const float gg = e < 4 ? g0[e & 3] : g1[e & 3], bb = e < 4 ? b0[e & 3] : b1[e & 3]; const float y = v[rr][e] * rstd * gg + bb; const float z = y * __builtin_amdgcn_rcpf(1.f + __expf(-y)); v[rr][e] = z; ss[rr] += z * z; } }
#pragma unroll
        for (int rr = 0; rr < 4; ++rr) ss[rr] = wave_sum(ss[rr]);
#pragma unroll
        for (int rr = 0; rr < 4; ++rr) { const int tok = 4 * wave + rr; const float r2 = __builtin_amdgcn_rsqf(ss[rr] * (1.f / CW) + EPS);
            u32x4 o; o.x = pk2bf(v[rr][0] * r2, v[rr][1] * r2); o.y = pk2bf(v[rr][2] * r2, v[rr][3] * r2); o.z = pk2bf(v[rr][4] * r2, v[rr][5] * r2); o.w = pk2bf(v[rr][6] * r2, v[rr][7] * r2);
            *(u32x4*)(MX + (rowb + t0 + tok) * CW + 8 * lane) = o; }
    }
    __syncthreads();
}

constexpr int AT_K = 0, AT_V = 16384, AT_O = 32768, AT_L = 65536;
typedef short v4i16_t __attribute__((ext_vector_type(4)));
__device__ __forceinline__ void at_qk(f32x16& p0, f32x16& p1, const LAS unsigned char* kt, const b16x8 (&qf)[4], int r32, int hi) {
#pragma unroll
    for (int r = 0; r < 16; ++r) { p0[r] = -SM_OFF; p1[r] = -SM_OFF; }
#pragma unroll
    for (int ks = 0; ks < 4; ++ks) {
        const int k0 = r32, k1 = 32 + r32;
        const b16x8 a0 = *(const LAS b16x8*)(kt + k0 * 128 + (((2 * ks + hi) ^ ((k0 >> 1) & 7)) * 16));
        const b16x8 a1 = *(const LAS b16x8*)(kt + k1 * 128 + (((2 * ks + hi) ^ ((k1 >> 1) & 7)) * 16));
        p0 = __builtin_amdgcn_mfma_f32_32x32x16_bf16(a0, qf[ks], p0, 0, 0, 0);
        p1 = __builtin_amdgcn_mfma_f32_32x32x16_bf16(a1, qf[ks], p1, 0, 0, 0);
    }
}
template <bool PRE, bool HASNEXT> __device__ __forceinline__ void attn_unit(const Params& p, LAS unsigned char* lds, int b, int h, int qt, int tid, int wave, int lane, int nb, int nh, int nqt, b16x8 (&qfio)[4], u32x4& mwio) {
    const size_t rowb = (size_t)b * SEQ; const int q0 = qt * 256, NT = 4 * (qt + 1);
    const u16* Q = (const u16*)(p.ws + WS_Q); const u16* Kg = (const u16*)(p.ws + WS_K); const u16* Vg = (const u16*)(p.ws + WS_V);
    const unsigned* MK = (const unsigned*)(p.ws + WS_MASK);
    const int r32 = lane & 31, hi = lane >> 5;
    const int qrow = q0 + 32 * wave + r32;
    b16x8 qf[4];
    if (PRE) {
#pragma unroll
      for (int ks = 0; ks < 4; ++ks) qf[ks] = qfio[ks];
    } else { const u16* src = Q + (rowb + qrow) * AW + h * 64 + 8 * hi;
#pragma unroll
      for (int ks = 0; ks < 4; ++ks) qf[ks] = *(const b16x8*)(src + 16 * ks); }
    const unsigned* mrow = MK + (rowb + qrow) * 256;
    f32x16 o0 = {0.f, 0.f, 0.f, 0.f, 0.f, 0.f, 0.f, 0.f, 0.f, 0.f, 0.f, 0.f, 0.f, 0.f, 0.f, 0.f}, o1 = o0;
    f32x16 lacc = o0;
    const b16x8 ones = __builtin_bit_cast(b16x8, (u32x4){0x3f803f80u, 0x3f803f80u, 0x3f803f80u, 0x3f803f80u});
    const int kkey = 8 * wave + (lane >> 3), kch = (lane & 7) ^ ((kkey >> 1) & 7);
    const u16* kg = Kg + (rowb + kkey) * AW + h * 64 + kch * 8;
    const u16* vg = Vg + (rowb + 16 * (wave & 3) + (lane >> 2)) * AW + h * 64 + 32 * (wave >> 2) + 8 * (lane & 3);
    const int dma_off = wave * 1024;
#define AT_DMA(gp, ldsoff) __builtin_amdgcn_global_load_lds((const unsigned*)(gp), (LAS unsigned*)(lds + (ldsoff) + dma_off), 16, 0, 0)
    u32x4 mq;
    if (PRE) mq = mwio;
    else { AT_DMA(kg, AT_K); AT_DMA(kg + (size_t)64 * AW, AT_K + 8192); AT_DMA(vg, AT_V); mq = *(const u32x4*)(mrow); }
    __syncthreads();
    f32x16 sA, sB, sC_, sD_;
    at_qk(sA, sB, lds + AT_K, qf, r32, hi);
    __syncthreads();
    const int g16 = lane >> 4, q4 = (lane & 15) >> 2, pp = lane & 3;
    const int vb = (g16 & 1) * 32 + pp * 8 + (4 * (g16 >> 1) + q4) * 64;
#define AT_STEP(C0, C1, N0, N1, t, MWX, MWY) do { \
        const int tk_ = (t) + 2 < NT ? (t) + 2 : NT - 1, tv_ = (t) + 1 < NT ? (t) + 1 : NT - 1; \
        AT_DMA(kg + (size_t)tk_ * 64 * AW, AT_K + ((t) & 1) * 8192);              \
        AT_DMA(vg + (size_t)tv_ * 64 * AW, AT_V + (((t) + 1) & 1) * 8192);        \
        at_qk(N0, N1, lds + AT_K + (((t) + 1) & 1) * 8192, qf, r32, hi); \
        const unsigned w0_ = (MWX) >> (4 * hi), w1_ = (MWY) >> (4 * hi); \
        _Pragma("unroll") for (int r = 0; r < 16; ++r) { const int pos_ = (r & 3) + 8 * (r >> 2); \
            const float e0_ = __builtin_amdgcn_exp2f(C0[r]); int m0_ = __builtin_amdgcn_sbfe((int)w0_, pos_, 1); asm("" : "+v"(m0_)); \
            C0[r] = __builtin_bit_cast(float, __builtin_bit_cast(int, e0_) & m0_); } \
        b16x8 pa_[4]; \
        _Pragma("unroll") for (int s_ = 0; s_ < 2; ++s_) { u32x4 w_; \
            _Pragma("unroll") for (int j = 0; j < 4; ++j) w_[j] = pk2bf(C0[8 * s_ + 2 * j], C0[8 * s_ + 2 * j + 1]); \
            pa_[s_] = __builtin_bit_cast(b16x8, w_); } \
        _Pragma("unroll") for (int r = 0; r < 16; ++r) { const int pos_ = (r & 3) + 8 * (r >> 2); \
            const float e1_ = __builtin_amdgcn_exp2f(C1[r]); int m1_ = __builtin_amdgcn_sbfe((int)w1_, pos_, 1); asm("" : "+v"(m1_)); \
            C1[r] = __builtin_bit_cast(float, __builtin_bit_cast(int, e1_) & m1_); } \
        _Pragma("unroll") for (int s_ = 0; s_ < 2; ++s_) { u32x4 w_; \
            _Pragma("unroll") for (int j = 0; j < 4; ++j) w_[j] = pk2bf(C1[8 * s_ + 2 * j], C1[8 * s_ + 2 * j + 1]); \
            pa_[2 + s_] = __builtin_bit_cast(b16x8, w_); } \
        { const LAS unsigned char* vt_ = lds + AT_V + ((t) & 1) * 8192; \
          _Pragma("unroll") for (int s_ = 0; s_ < 4; ++s_) \
          _Pragma("unroll") for (int d0 = 0; d0 < 2; ++d0) { \
              const LAS unsigned char* a_ = vt_ + vb + s_ * 1024 + d0 * 4096; \
              const v4i16_t lo_ = __builtin_amdgcn_ds_read_tr16_b64_v4i16((LAS v4i16_t*)a_); \
              const v4i16_t hi4_ = __builtin_amdgcn_ds_read_tr16_b64_v4i16((LAS v4i16_t*)(a_ + 512)); \
              const s16x8 bv_ = (s16x8){lo_[0], lo_[1], lo_[2], lo_[3], hi4_[0], hi4_[1], hi4_[2], hi4_[3]}; \
              if (d0 == 0) { o0 = __builtin_amdgcn_mfma_f32_32x32x16_bf16(pa_[s_], __builtin_bit_cast(b16x8, bv_), o0, 0, 0, 0); lacc = __builtin_amdgcn_mfma_f32_32x32x16_bf16(pa_[s_], ones, lacc, 0, 0, 0); } \
              else o1 = __builtin_amdgcn_mfma_f32_32x32x16_bf16(pa_[s_], __builtin_bit_cast(b16x8, bv_), o1, 0, 0, 0); } } \
          \
        _Pragma("unroll") for (int i_ = 0; i_ < 8; ++i_) { __builtin_amdgcn_sched_group_barrier(0x100, 2, 0); __builtin_amdgcn_sched_group_barrier(0x008, 1, 0); __builtin_amdgcn_sched_group_barrier(0x002, 7, 0); } \
        _Pragma("unroll") for (int i_ = 0; i_ < 8; ++i_) { __builtin_amdgcn_sched_group_barrier(0x100, 2, 0); __builtin_amdgcn_sched_group_barrier(0x008, 1, 0); __builtin_amdgcn_sched_group_barrier(0x002, 7, 0); } \
        __syncthreads(); } while (0)
    for (int t = 0; t < NT; t += 2) {
        const int tn_ = t + 2 < NT ? t + 2 : NT - 2;
        const u32x4 mqN = *(const u32x4*)(mrow + 2 * tn_);
        AT_STEP(sA, sB, sC_, sD_, t, mq.x, mq.y);
        AT_STEP(sC_, sD_, sA, sB, t + 1, mq.z, mq.w);
        mq = mqN;
    }
#undef AT_STEP
    if (HASNEXT) {
        const size_t rowb2 = (size_t)nb * SEQ; const int qrow2 = nqt * 256 + 32 * wave + r32;
        const u16* src2 = Q + (rowb2 + qrow2) * AW + nh * 64 + 8 * hi;
#pragma unroll
        for (int ks = 0; ks < 4; ++ks) qfio[ks] = *(const b16x8*)(src2 + 16 * ks);
        const u16* kg2 = Kg + (rowb2 + kkey) * AW + nh * 64 + kch * 8;
        const u16* vg2 = Vg + (rowb2 + 16 * (wave & 3) + (lane >> 2)) * AW + nh * 64 + 32 * (wave >> 2) + 8 * (lane & 3);
        AT_DMA(kg2, AT_K); AT_DMA(kg2 + (size_t)64 * AW, AT_K + 8192); AT_DMA(vg2, AT_V);
        mwio = *(const u32x4*)(MK + (rowb2 + qrow2) * 256);
    }
#undef AT_DMA
    LAS u16* stg = (LAS u16*)(lds + AT_O + wave * 4096);
#pragma unroll
    for (int r = 0; r < 16; ++r) { const int orow = (r & 3) + 8 * (r >> 2) + 4 * hi; const float rl = __builtin_amdgcn_rcpf(lacc[r]);
        stg[orow * 64 + r32] = (u16)f2bf(o0[r] * rl); stg[orow * 64 + 32 + r32] = (u16)f2bf(o1[r] * rl); }
    LDS_WAIT(); asm volatile("" ::: "memory");
    { const int row = lane >> 1, hf = lane & 1; float ss = 0.f; u32x4 v[4];
#pragma unroll
      for (int j = 0; j < 4; ++j) { v[j] = *(const LAS u32x4*)(stg + row * 64 + hf * 32 + j * 8);
#pragma unroll
          for (int e = 0; e < 4; ++e) { const float a = bf2f((u16)(v[j][e] & 0xffff)), c = bf2f((u16)(v[j][e] >> 16)); ss += a * a + c * c; } }
      ss += __shfl_xor(ss, 1);
      const size_t grow = rowb + q0 + 32 * wave + row;
      u16* dst = (u16*)(p.ws + WS_ATT) + grow * AW + h * 64 + hf * 32;
#pragma unroll
      for (int j = 0; j < 4; ++j) *(u32x4*)(dst + j * 8) = v[j];
      if (hf == 0) ((float*)(p.ws + WS_SSP))[grow * 8 + h] = ss; }
    __syncthreads();
}

#ifdef DEBUG_CHECK
__device__ __forceinline__ void dbg_attn_check(const Params& p, int gw, int NGW, int lane) {
    const u16* Q = (const u16*)(p.ws + WS_Q); const u16* Kg = (const u16*)(p.ws + WS_K); const u16* Vg = (const u16*)(p.ws + WS_V);
    const unsigned* MK = (const unsigned*)(p.ws + WS_MASK); const u16* A = (const u16*)(p.ws + WS_ATT);
    unsigned* ctl = (unsigned*)(p.ws + WS_CTL);
    for (int it = gw; it < (M / 16) * 8; it += NGW) {
        const int row = (it >> 3) * 16 + 5, h = it & 7; const int b = row / SEQ, t = row % SEQ; const size_t rowb = (size_t)b * SEQ;
        const int N = 64 * (t / 64 + 1);
        float q[64];
#pragma unroll
        for (int d = 0; d < 64; ++d) q[d] = bf2f(Q[(size_t)row * AW + h * 64 + d]);
        float o[64]; float l = 0.f;
#pragma unroll
        for (int d = 0; d < 64; ++d) o[d] = 0.f;
        for (int key = lane; key < N; key += 64) {
            const unsigned w = MK[(size_t)row * 256 + (key >> 5)];
            if ((w >> (key & 31)) & 1u) {
                float s = 0.f;
#pragma unroll
                for (int d = 0; d < 64; ++d) s += q[d] * bf2f(Kg[(rowb + key) * AW + h * 64 + d]);
                const float pr = exp2f(s - SM_OFF); l += pr;
#pragma unroll
                for (int d = 0; d < 64; ++d) o[d] += pr * bf2f(Vg[(rowb + key) * AW + h * 64 + d]);
            }
        }
        l = wave_sum(l); float maxerr = 0.f, maxref = 0.f;
#pragma unroll
        for (int d = 0; d < 64; ++d) { const float od = wave_sum(o[d]) / l; const float got = bf2f(A[(size_t)row * AW + h * 64 + d]); maxerr = fmaxf(maxerr, fabsf(od - got)); maxref = fmaxf(maxref, fabsf(od)); }
        if (lane == 0 && !(maxerr <= 0.03f * maxref + 1e-3f)) atomicAdd(&ctl[8], 1u);
    }
}
__device__ __forceinline__ void dbg_idx_check(const Params& p, int gw, int NGW, int lane) {
    const u16* IQ = (const u16*)(p.ws + WS_IQ); const u16* IK = (const u16*)(p.ws + WS_IK); const float* IW = (const float*)(p.ws + WS_IW);
    const unsigned* MK = (const unsigned*)(p.ws + WS_MASK); unsigned* ctl = (unsigned*)(p.ws + WS_CTL);
    for (int it = gw; it < M / 16; it += NGW) {
        const int row = it * 16 + 5; const int b = row / SEQ, t = row % SEQ; const size_t rowb = (size_t)b * SEQ; const int N = 64 * (t / 64 + 1);
        float minsel = 3e38f, maxun = -3e38f; int cnt = 0;
        for (int key = lane; key < N; key += 64) {
            float sc = 0.f;
            for (int h = 0; h < 8; ++h) { float d = 0.f;
                for (int e = 0; e < 64; ++e) d += (float)__builtin_bit_cast(_Float16, IQ[(size_t)row * 512 + h * 64 + e]) * (float)__builtin_bit_cast(_Float16, IK[(rowb + key) * 64 + e]);
                sc += IW[(size_t)row * 8 + h] * fmaxf(d, 0.f); }
            const unsigned w = MK[(size_t)row * 256 + (key >> 5)];
            if ((w >> (key & 31)) & 1u) { minsel = fminf(minsel, sc); ++cnt; } else maxun = fmaxf(maxun, sc);
        }
        int extra = 0; for (int wi = N / 32 + lane; wi < 256; wi += 64) extra += __popc(MK[(size_t)row * 256 + wi]);
#pragma unroll
        for (int o = 1; o < 64; o <<= 1) { minsel = fminf(minsel, __shfl_xor(minsel, o)); maxun = fmaxf(maxun, __shfl_xor(maxun, o)); cnt += __shfl_xor(cnt, o); extra += __shfl_xor(extra, o); }
        const int want = N < 256 ? N : 256;
        if (lane == 0) { if (cnt != want) { atomicAdd(&ctl[9], 1u); atomicMax(&ctl[12], (unsigned)(N / 64)); atomicMax(&ctl[13], (unsigned)(cnt > want ? cnt - want : want - cnt)); }
            else if (extra != 0) atomicAdd(&ctl[10], 1u);
            else if (N > 256 && !(minsel >= maxun - 2e-3f * (fabsf(maxun) + 1.f))) atomicAdd(&ctl[11], 1u); }
    }
}
__device__ __forceinline__ void dbg_encode(const Params& p, int gw, int NGW, int lane) {
    const unsigned* ctl = (const unsigned*)(p.ws + WS_CTL);
    const unsigned cb = __hip_atomic_load(&ctl[9], __ATOMIC_RELAXED, __HIP_MEMORY_SCOPE_AGENT), eb = __hip_atomic_load(&ctl[10], __ATOMIC_RELAXED, __HIP_MEMORY_SCOPE_AGENT), ob = __hip_atomic_load(&ctl[11], __ATOMIC_RELAXED, __HIP_MEMORY_SCOPE_AGENT);
    const unsigned n64 = __hip_atomic_load(&ctl[12], __ATOMIC_RELAXED, __HIP_MEMORY_SCOPE_AGENT), dc = __hip_atomic_load(&ctl[13], __ATOMIC_RELAXED, __HIP_MEMORY_SCOPE_AGENT);
    const unsigned c14 = __hip_atomic_load(&ctl[14], __ATOMIC_RELAXED, __HIP_MEMORY_SCOPE_AGENT), c15 = __hip_atomic_load(&ctl[15], __ATOMIC_RELAXED, __HIP_MEMORY_SCOPE_AGENT);
    if (cb == 0 && eb == 0 && ob == 0 && c14 == 0 && c15 == 0) return;
    const float s = c14 ? 0.5f : (c15 ? -1.f : 0.f);
    for (int m = gw; m < M; m += NGW) { const f32x4* xr = (const f32x4*)(p.x + (size_t)m * DM) + lane; f32x4* o = (f32x4*)(p.out + (size_t)m * DM) + lane;
#pragma unroll
        for (int j = 0; j < 4; ++j) o[64 * j] = xr[64 * j] * s; }
    if (gw == 0 && lane == 0) { p.out[0] = 1000.f * (float)cb; p.out[1] = 0.f; }
    (void)n64; (void)dc;
}
#endif

__global__ void __launch_bounds__(NTHR, 2) fwd_megakernel(Params p) {
    extern __shared__ __attribute__((aligned(16))) unsigned char lds_raw[];
    LAS unsigned char* lds = (LAS unsigned char*)lds_raw;
    const int tid = threadIdx.x;
    const int G = gridDim.x; const int bx = blockIdx.x; const int vcu = (G % 8 == 0) ? (bx % 8) * (G / 8) + bx / 8 : bx;
    volatile LAS unsigned* MISC = (volatile LAS unsigned*)(lds + MISC_OFF);
    for (int u = tid; u < (LDS_BYTES - RING_BYTES) / 4; u += NTHR) ((LAS unsigned*)(lds + RING_BYTES))[u] = 0u;
    __syncthreads();
    XcdBarrier bar = xcd_barrier_post((unsigned*)(p.ws + WS_CTL) + CW_BAR, MISC + 8);
    const int NGW = G * NWAVES;

#define PH_IDS() const int tid_ = opaque_tid(); const int lane_ = tid_ & 63; const int wave_ = __builtin_amdgcn_readfirstlane(tid_ >> 6); const int gw_ = vcu * NWAVES + wave_
    REP(0) { PH_IDS(); p0_phase(p, lds, vcu, G, tid_, wave_, lane_); }
    xcd_barrier(bar);
    if (((REPEAT_MASK) >> 11) & 1) { for (int q_ = 0; q_ < 8; ++q_) xcd_barrier(bar); }
    REP(1) { PH_IDS(); p1_rows(p, gw_, NGW, lane_); if (G != 256) p1_extra(p, lds, vcu, G, tid_, wave_, lane_); }
    xcd_barrier(bar);
    REP(2) { const int n1_ = (rep_ == 1) ? 3072 : N1; pg8::Gemm g{(const u16*)(p.ws + WS_H), (const u16*)(p.ws + WS_H), (const u16*)(p.ws + WS_WIN), nullptr, M, n1_, DM, DM, DM / 64}; pg8::StaticOrder S; S.init(M, n1_, G, bx);
      EpiInProj E{p.ws, p.g_q, p.g_k};
      pg8::gemm_phase<EpiInProj, true>(lds, g, S, E);
      if (G == 256 && bx >= 64) { PH_IDS(); (void)gw_; late_weights(p, lds, (bx - 64) * NWAVES + wave_, 192 * NWAVES, wave_, lane_); __syncthreads();
          p1_extra(p, lds, bx - 64, G, tid_, wave_, lane_); }
      else if (G != 256) { PH_IDS(); late_weights(p, lds, gw_, NGW, wave_, lane_); }
      __syncthreads(); }
    xcd_barrier(bar);
    REP(3) if (G == 256) {
        const int b = vcu >> 7, i = vcu & 127;
        { PH_IDS(); (void)gw_; idx_unit<0>(p, lds, b, 255 - i, tid_, wave_, lane_); }
        { PH_IDS(); (void)gw_; idx_unit<0>(p, lds, b, i, tid_, wave_, lane_); }
    }
#ifdef IDX_VAR
    if (G == 256) {
        const int b = vcu >> 7, i = vcu & 127;
        { PH_IDS(); (void)gw_; idx_unit<IDX_VAR>(p, lds, b, 255 - i, tid_, wave_, lane_); }
        { PH_IDS(); (void)gw_; idx_unit<IDX_VAR>(p, lds, b, i, tid_, wave_, lane_); }
    }
#endif
    if (G == 256) {
        unsigned* cq = (unsigned*)(p.ws + WS_CTL) + CW_CONVQ;
        int u;
        { PH_IDS(); (void)gw_; (void)wave_; (void)lane_; if (tid_ == 0) MISC[16] = xb_add(cq, 1u); __syncthreads(); u = (int)MISC[16]; __syncthreads(); }
        while (u < 2 * 256) {
            PH_IDS(); (void)gw_;
            unsigned nxt = 0u; if (tid_ == 0) nxt = xb_add(cq, 1u);
            conv_unit(p, lds, u, tid_, wave_, lane_);
            if (tid_ == 0) MISC[16] = nxt;
            __syncthreads(); u = (int)MISC[16]; __syncthreads();
        }
    }
    xcd_barrier(bar);
    REP(4) if (G == 256) {
        const int bh = vcu >> 4, j = vcu & 15;
        b16x8 qfc[4]; u32x4 mwc;
        { PH_IDS(); (void)gw_; attn_unit<false, true>(p, lds, bh >> 3, bh & 7, 31 - j, tid_, wave_, lane_, bh >> 3, bh & 7, j, qfc, mwc); }
        { PH_IDS(); (void)gw_; attn_unit<true, false>(p, lds, bh >> 3, bh & 7, j, tid_, wave_, lane_, 0, 0, 0, qfc, mwc); }
    }
    xcd_barrier(bar);
#ifdef DEBUG_CHECK
    { PH_IDS(); dbg_attn_check(p, gw_, NGW, lane_); dbg_idx_check(p, gw_, NGW, lane_); }
    xcd_barrier(bar);
#endif
    REP(6) { pg8::Gemm g{(const u16*)(p.ws + WS_ATT), (const u16*)(p.ws + WS_CONV), (const u16*)(p.ws + WS_WOUT), nullptr, M, DM, DM, AW, AW / 64}; pg8::StaticOrder S; S.init(M, DM, G, bx);
      EpiOut E{p.x, (u16*)(p.ws + WS_X1B), (float*)(p.ws + (rep_ == 0 ? WS_SS2 : WS_H)), (const float*)(p.ws + WS_MOD), (const float*)(p.ws + WS_SSP)};
      pg8::gemm_phase<EpiOut, false>(lds, g, S, E); }
    xcd_barrier(bar);
    REP(8) { pg8::Gemm g{(const u16*)(p.ws + WS_X1B), (const u16*)(p.ws + WS_X1B), (const u16*)(p.ws + WS_W1), (const u16*)(p.ws + WS_W1) + (size_t)DFF * DM, M, DFF, DM, DM, DM / 64}; pg8::StaticOrder S; S.init(M, DFF, G, bx);
      EpiFF1 E{(u16*)(p.ws + WS_F1), (const float*)(p.ws + WS_SS2), (const float*)(p.ws + WS_CB)};
      pg8::gemm_phase<EpiFF1, false>(lds, g, S, E); }
    xcd_barrier(bar);
    REP(10) { pg8::Gemm g{(const u16*)(p.ws + WS_F1), (const u16*)(p.ws + WS_F1), (const u16*)(p.ws + WS_W2), nullptr, M, DM, DFF, DFF, DFF / 64}; pg8::StaticOrder S; S.init(M, DM, G, bx);
      EpiFinal E{(const u16*)(p.ws + WS_X1B), p.out, (const float*)(p.ws + WS_MOD)};
      pg8::gemm_phase<EpiFinal, false>(lds, g, S, E); }
#ifdef DEBUG_CHECK
    xcd_barrier(bar);
    { PH_IDS(); dbg_encode(p, gw_, NGW, lane_); }
#endif
}

extern "C" void kernel_launch(void* const* d_in, const int* in_sizes, int n_in, void* d_out, int out_size, void* d_ws, size_t ws_size, hipStream_t stream) {
    static int grid = 0;
    if (grid == 0) {
        int dev = 0, cus = 0, per_cu = 0;
        if (n_in != 18 || out_size != M * DM || ws_size < WS_END) { fprintf(stderr, "kernel_launch: unexpected shapes (n_in %d out %d ws %zu)\n", n_in, out_size, ws_size); grid = -1; return; }
        if (hipGetDevice(&dev) != hipSuccess || hipDeviceGetAttribute(&cus, hipDeviceAttributeMultiprocessorCount, dev) != hipSuccess) { grid = -1; return; }
        if (hipFuncSetAttribute((const void*)fwd_megakernel, hipFuncAttributeMaxDynamicSharedMemorySize, LDS_BYTES) != hipSuccess) { fprintf(stderr, "kernel_launch: hipFuncSetAttribute failed\n"); grid = -1; return; }
        if (hipOccupancyMaxActiveBlocksPerMultiprocessor(&per_cu, (const void*)fwd_megakernel, NTHR, LDS_BYTES) != hipSuccess || per_cu < 1) { fprintf(stderr, "kernel_launch: occupancy query says %d\n", per_cu); per_cu = 1; }
        (void)hipGetLastError();
        grid = cus;
        if (grid != 256) fprintf(stderr, "kernel_launch: %d CUs, expected 256\n", grid);
    }
    if (grid < 0) return;
    if (hipMemsetAsync((char*)d_ws + WS_CTL, 0, CTL_ZERO_BYTES, stream) != hipSuccess) return;
    Params p{};
    const float** pp = (const float**)&p;
    for (int i = 0; i < 18; ++i) pp[i] = (const float*)d_in[i];
    p.out = (float*)d_out; p.ws = (unsigned char*)d_ws;
    void* args[] = {&p};
    hipError_t e = hipLaunchCooperativeKernel((void*)fwd_megakernel, dim3(grid), dim3(NTHR), args, LDS_BYTES, stream);
    if (e != hipSuccess) fprintf(stderr, "cooperative launch failed: %s (grid %d)\n", hipGetErrorString(e), grid);
}
```
